# Optimizing an MI355X kernel written in HIP

```python
import jax, jax.numpy as jnp
from jax import lax
import numpy as np

D_MODEL = 1024
BATCH = 8
SEQ = 8192
DEPTH = 1
DEC_BATCH = 16
DEC_SEQ = 32
PAST_LEN = 2048

CHUNK = 64
N_Q_HEADS = 16
N_KV_HEADS = 4
HEAD_DIM = 64
Q_PER_KV = N_Q_HEADS // N_KV_HEADS
ATT_WIDTH = N_Q_HEADS * HEAD_DIM
KV_WIDTH = N_KV_HEADS * HEAD_DIM
WINDOW = 128
WINDOW_CHUNKS = WINDOW // CHUNK
ROT_DIM = HEAD_DIM // 4
ROPE_THETA = 500000.0
SSM_WIDTH = 2 * D_MODEL
SSM_HEAD_DIM = 64
SSM_HEADS = SSM_WIDTH // SSM_HEAD_DIM
SSM_GROUPS = 4
HEADS_PER_GROUP = SSM_HEADS // SSM_GROUPS
SSM_STATE = 128
BC_WIDTH = SSM_GROUPS * SSM_STATE
CONV_W = 4
CONV_CH = SSM_WIDTH + 2 * BC_WIDTH
EPS = 1e-6
COL_SIZES = (ATT_WIDTH, KV_WIDTH, KV_WIDTH, ATT_WIDTH, SSM_WIDTH, CONV_CH, SSM_HEADS, D_MODEL, D_MODEL)
IN_WIDTH = ATT_WIDTH + 2 * KV_WIDTH + ATT_WIDTH + SSM_WIDTH + CONV_CH + SSM_HEADS + 2 * D_MODEL

kernel_name = 'hybrid_swa_sink_ssd_streaming_step'


def _rms_norm(x, w):
    xf = x.astype(jnp.float32)
    y = xf * lax.rsqrt(jnp.mean(xf * xf, axis=-1, keepdims=True) + EPS)
    return (y * w.astype(jnp.float32)).astype(x.dtype)


def _split_cols(proj):
    parts, off = [], 0
    for size in COL_SIZES:
        parts.append(proj[..., off:off + size])
        off += size
    return parts


def _partial_rope(x, pos):
    half = ROT_DIM // 2
    inv = ROPE_THETA ** (-(jnp.arange(half, dtype=jnp.float32) * 2.0 / ROT_DIM))
    ang = pos.astype(jnp.float32)[:, None] * inv[None, :]
    cos = jnp.cos(ang)[None, :, None, :]
    sin = jnp.sin(ang)[None, :, None, :]
    xf = x.astype(jnp.float32)
    x1, x2, rest = xf[..., :half], xf[..., half:ROT_DIM], xf[..., ROT_DIM:]
    return jnp.concatenate([x1 * cos - x2 * sin, x2 * cos + x1 * sin, rest], axis=-1).astype(x.dtype)


def _sink_softmax(s, sinks):
    sk = sinks.astype(jnp.float32).reshape(N_KV_HEADS, Q_PER_KV, 1, 1)
    m = jnp.maximum(jnp.max(s, axis=-1, keepdims=True), sk)
    p = jnp.exp(s - m)
    return p / (jnp.sum(p, axis=-1, keepdims=True) + jnp.exp(sk - m))


def _banded_window_attention(q, k, v, sinks):
    bsz, L = q.shape[:2]
    n_c = L // CHUNK
    qc = q.reshape(bsz, n_c, CHUNK, N_KV_HEADS, Q_PER_KV, HEAD_DIM)
    pad = ((0, 0), (WINDOW_CHUNKS, 0), (0, 0), (0, 0), (0, 0))
    kp = jnp.pad(k.reshape(bsz, n_c, CHUNK, N_KV_HEADS, HEAD_DIM), pad)
    vp = jnp.pad(v.reshape(bsz, n_c, CHUNK, N_KV_HEADS, HEAD_DIM), pad)
    k_band = jnp.concatenate([kp[:, j:j + n_c] for j in range(WINDOW_CHUNKS + 1)], axis=2)
    v_band = jnp.concatenate([vp[:, j:j + n_c] for j in range(WINDOW_CHUNKS + 1)], axis=2)
    key_chunk = (jnp.arange(n_c)[:, None] - WINDOW_CHUNKS
                 + (jnp.arange((WINDOW_CHUNKS + 1) * CHUNK) // CHUNK)[None, :])
    valid = key_chunk >= 0
    s = jnp.einsum('bcqhgd,bckhd->bchgqk', qc, k_band).astype(jnp.float32) * (HEAD_DIM ** -0.5)
    s = jnp.where(valid[None, :, None, None, None, :], s, -jnp.inf)
    p = _sink_softmax(s, sinks).astype(v.dtype)
    out = jnp.einsum('bchgqk,bckhd->bcqhgd', p, v_band)
    return out.reshape(bsz, L, ATT_WIDTH)


def _cached_window_attention(q, k, v, cache_k, cache_v, sinks):
    bsz, L = q.shape[:2]
    k_all = jnp.concatenate([cache_k.astype(k.dtype), k], axis=1)
    v_all = jnp.concatenate([cache_v.astype(v.dtype), v], axis=1)
    qg = q.reshape(bsz, L, N_KV_HEADS, Q_PER_KV, HEAD_DIM)
    s = jnp.einsum('bqhgd,bkhd->bhgqk', qg, k_all).astype(jnp.float32) * (HEAD_DIM ** -0.5)
    p = _sink_softmax(s, sinks).astype(v.dtype)
    out = jnp.einsum('bhgqk,bkhd->bqhgd', p, v_all)
    return out.reshape(bsz, L, ATT_WIDTH)


def _causal_dwconv(x, buf, w, b):
    L = x.shape[1]
    xpad = jnp.concatenate([buf.astype(x.dtype), x], axis=1)
    y = b[None, None, :]
    for tap in range(CONV_W):
        y = y + xpad[:, tap:tap + L] * w[tap][None, None, :]
    return y, xpad[:, L:]


def _ssd_chunk(h0, xs, dt, bm, cm, a):
    bsz, Q = xs.shape[:2]
    x5 = xs.reshape(bsz, Q, SSM_GROUPS, HEADS_PER_GROUP, SSM_HEAD_DIM).astype(jnp.float32)
    dt4 = dt.reshape(bsz, Q, SSM_GROUPS, HEADS_PER_GROUP)
    cum = jnp.cumsum(dt4 * a.reshape(SSM_GROUPS, HEADS_PER_GROUP), axis=1)
    seg = cum[:, :, None] - cum[:, None, :]
    causal = jnp.tril(jnp.ones((Q, Q), dtype=bool))[None, :, :, None, None]
    decay = jnp.exp(jnp.where(causal, seg, -jnp.inf))
    bf, cf = bm.astype(jnp.float32), cm.astype(jnp.float32)
    cb = jnp.einsum('bign,bjgn->bijg', cf, bf)
    y = jnp.einsum('bijg,bijgh,bjgh,bjghp->bighp', cb, decay, dt4, x5)
    h0g = h0.reshape(bsz, SSM_GROUPS, HEADS_PER_GROUP, SSM_HEAD_DIM, SSM_STATE)
    y = y + jnp.einsum('bign,bghpn,bigh->bighp', cf, h0g, jnp.exp(cum))
    to_end = jnp.exp(cum[:, -1:] - cum) * dt4
    h_new = (jnp.exp(cum[:, -1])[..., None, None] * h0g
             + jnp.einsum('bjgn,bjgh,bjghp->bghpn', bf, to_end, x5))
    return (y.reshape(bsz, Q, SSM_HEADS, SSM_HEAD_DIM),
            h_new.reshape(bsz, SSM_HEADS, SSM_HEAD_DIM, SSM_STATE))


def _layer(x, pos, is_prompt, cache_k, cache_v, conv_buf, ssm_h,
           pre_norm_w, w_in, conv_w, conv_b, dt_bias, a_log, d_skip, sinks,
           ssm_norm_w, w_attn_o, w_ssm_o, w_out, post_norm_w):
    bsz, L, _ = x.shape
    h = _rms_norm(x, pre_norm_w)
    proj = h @ w_in
    q, k, v, g_att, z, xbc, dt_raw, gate_a, gate_s = _split_cols(proj)

    q = _partial_rope(q.reshape(bsz, L, N_Q_HEADS, HEAD_DIM), pos)
    k = _partial_rope(k.reshape(bsz, L, N_KV_HEADS, HEAD_DIM), pos)
    v = v.reshape(bsz, L, N_KV_HEADS, HEAD_DIM)
    if is_prompt:
        att = _banded_window_attention(q, k, v, sinks)
        n_keep = min(WINDOW, L)
        new_k, new_v = k[:, L - n_keep:], v[:, L - n_keep:]
    else:
        att = _cached_window_attention(q, k, v, cache_k, cache_v, sinks)
        new_k, new_v = k, v
    branch_a = (att * jax.nn.silu(g_att)) @ w_attn_o

    xbc_c, new_buf = _causal_dwconv(xbc, conv_buf, conv_w, conv_b)
    xbc_c = jax.nn.silu(xbc_c)
    xs = xbc_c[..., :SSM_WIDTH].reshape(bsz, L, SSM_HEADS, SSM_HEAD_DIM)
    bm = xbc_c[..., SSM_WIDTH:SSM_WIDTH + BC_WIDTH].reshape(bsz, L, SSM_GROUPS, SSM_STATE)
    cm = xbc_c[..., SSM_WIDTH + BC_WIDTH:].reshape(bsz, L, SSM_GROUPS, SSM_STATE)
    dt = jax.nn.softplus(dt_raw.astype(jnp.float32) + dt_bias.astype(jnp.float32))
    a = -jnp.exp(a_log.astype(jnp.float32))
    h0 = ssm_h.astype(jnp.float32)
    if is_prompt:
        n_c = L // CHUNK
        to_chunks = lambda t: jnp.swapaxes(t.reshape((bsz, n_c, CHUNK) + t.shape[2:]), 0, 1)

        def step(carry, inp):
            y_c, carry = _ssd_chunk(carry, inp[0], inp[1], inp[2], inp[3], a)
            return carry, y_c

        h_new, ys = lax.scan(step, h0, (to_chunks(xs), to_chunks(dt), to_chunks(bm), to_chunks(cm)))
        y = jnp.swapaxes(ys, 0, 1).reshape(bsz, L, SSM_HEADS, SSM_HEAD_DIM)
    else:
        y, h_new = _ssd_chunk(h0, xs, dt, bm, cm, a)
    y = y + xs.astype(jnp.float32) * d_skip.astype(jnp.float32)[None, None, :, None]
    yz = y.reshape(bsz, L, SSM_WIDTH).astype(x.dtype) * jax.nn.silu(z)
    yg = yz.reshape(bsz, L, SSM_GROUPS, SSM_WIDTH // SSM_GROUPS).astype(jnp.float32)
    yg = yg * lax.rsqrt(jnp.mean(yg * yg, axis=-1, keepdims=True) + EPS)
    yz = (yg.reshape(bsz, L, SSM_WIDTH) * ssm_norm_w.astype(jnp.float32)).astype(x.dtype)
    branch_s = yz @ w_ssm_o

    merged = jax.nn.sigmoid(gate_a) * branch_a + jax.nn.sigmoid(gate_s) * branch_s
    out = merged @ w_out
    return x + _rms_norm(out, post_norm_w), new_k, new_v, new_buf, h_new


def setup_inputs(seed: int = 0) -> dict:
    key = jax.random.key(seed)
    ks = jax.random.split(key, 24)
    f32 = jnp.float32
    n = lambda k_, shape, s: jax.random.normal(k_, shape, f32) * s
    win_cache = min(WINDOW, PAST_LEN)
    dt0 = jnp.exp(jax.random.uniform(ks[10], (DEPTH, SSM_HEADS), f32, np.log(1e-3), np.log(1e-1)))
    return {
        'x_prompt': n(ks[0], (BATCH, SEQ, D_MODEL), 1.0),
        'x_sample': n(ks[1], (DEC_BATCH, DEC_SEQ, D_MODEL), 1.0),
        'cache_k': n(ks[2], (DEPTH, DEC_BATCH, win_cache, N_KV_HEADS, HEAD_DIM), 1.0),
        'cache_v': n(ks[3], (DEPTH, DEC_BATCH, win_cache, N_KV_HEADS, HEAD_DIM), 1.0),
        'state_conv': n(ks[4], (DEPTH, DEC_BATCH, CONV_W - 1, CONV_CH), 1.0),
        'state_ssm': n(ks[5], (DEPTH, DEC_BATCH, SSM_HEADS, SSM_HEAD_DIM, SSM_STATE), 0.5),
        'pre_norm_w': 1.0 + n(ks[6], (DEPTH, D_MODEL), 0.01),
        'w_in': n(ks[7], (DEPTH, D_MODEL, IN_WIDTH), D_MODEL ** -0.5),
        'conv_w': n(ks[8], (DEPTH, CONV_W, CONV_CH), CONV_W ** -0.5),
        'conv_b': n(ks[9], (DEPTH, CONV_CH), 0.01),
        'dt_bias': dt0 + jnp.log(-jnp.expm1(-dt0)),
        'a_log': jnp.log(jax.random.uniform(ks[11], (DEPTH, SSM_HEADS), f32, 1.0, 16.0)),
        'd_skip': 1.0 + n(ks[12], (DEPTH, SSM_HEADS), 0.1),
        'sinks': n(ks[13], (DEPTH, N_Q_HEADS), 0.5),
        'ssm_norm_w': 1.0 + n(ks[14], (DEPTH, SSM_WIDTH), 0.01),
        'w_attn_o': n(ks[15], (DEPTH, ATT_WIDTH, D_MODEL), ATT_WIDTH ** -0.5),
        'w_ssm_o': n(ks[16], (DEPTH, SSM_WIDTH, D_MODEL), SSM_WIDTH ** -0.5),
        'w_out': n(ks[17], (DEPTH, D_MODEL, D_MODEL), D_MODEL ** -0.5),
        'post_norm_w': 1.0 + n(ks[18], (DEPTH, D_MODEL), 0.01),
    }


def reference(x_prompt, x_sample, cache_k, cache_v, state_conv, state_ssm,
              pre_norm_w, w_in, conv_w, conv_b, dt_bias, a_log, d_skip, sinks,
              ssm_norm_w, w_attn_o, w_ssm_o, w_out, post_norm_w):
    bp, lp = x_prompt.shape[:2]
    ls = x_sample.shape[1]
    pos_p = jnp.arange(lp, dtype=jnp.float32)
    pos_s = PAST_LEN + jnp.arange(ls, dtype=jnp.float32)
    zero_buf = jnp.zeros((bp, CONV_W - 1, CONV_CH), x_prompt.dtype)
    zero_h = jnp.zeros((bp, SSM_HEADS, SSM_HEAD_DIM, SSM_STATE), jnp.float32)
    yp, ys = x_prompt, x_sample
    kp_l, vp_l, cp_l, sp_l, ks_l, vs_l, cs_l, ss_l = [], [], [], [], [], [], [], []
    for layer in range(DEPTH):
        wts = (pre_norm_w[layer], w_in[layer], conv_w[layer], conv_b[layer], dt_bias[layer],
               a_log[layer], d_skip[layer], sinks[layer], ssm_norm_w[layer], w_attn_o[layer],
               w_ssm_o[layer], w_out[layer], post_norm_w[layer])
        yp, kp, vp, cp, sp = _layer(yp, pos_p, True, None, None, zero_buf, zero_h, *wts)
        ys, ks_, vs, cs, ss = _layer(ys, pos_s, False, cache_k[layer], cache_v[layer],
                                     state_conv[layer], state_ssm[layer], *wts)
        kp_l.append(kp); vp_l.append(vp); cp_l.append(cp); sp_l.append(sp)
        ks_l.append(ks_); vs_l.append(vs); cs_l.append(cs); ss_l.append(ss)
    return (yp, ys,
            jnp.stack(kp_l), jnp.stack(vp_l), jnp.stack(cp_l), jnp.stack(sp_l),
            jnp.stack(ks_l), jnp.stack(vs_l), jnp.stack(cs_l), jnp.stack(ss_l))
```

```cpp
#include <hip/hip_runtime.h>
#include <hip/hip_cooperative_groups.h>
#include <cstdio>
namespace pg8 {
#define PG8_LAS __attribute__((address_space(3)))
typedef unsigned short bf16_t;
typedef short bf16x8 __attribute__((ext_vector_type(8)));
typedef float f32x4 __attribute__((ext_vector_type(4)));
typedef unsigned u32x4 __attribute__((ext_vector_type(4)));
constexpr int BM = 256, BK = 64, HALF = 128, HTB = HALF * BK * 2  , STAGE_BYTES = 8 * HTB, NXCD = 8, WGM = 8;

__host__ __device__ __forceinline__ int lds_byte(int r, int c) { const int st = (r >> 4) * 2 + (c >> 5), rr = r & 15, cc = c & 31, ob = rr * 64 + cc * 2; return st * 1024 + (ob ^ (((ob >> 9) & 1) << 5)); }
__host__ __device__ __forceinline__ void stage_rc(int b, int& R, int& C) { const int st = b / 1024, sb = b % 1024, swz = sb ^ (((sb >> 9) & 1) << 5); R = (st >> 1) * 16 + swz / 64; C = (st & 1) * 32 + (swz % 64) / 2; }
__host__ __device__ __forceinline__ int perm32(int rho) { const int n = rho >> 4, i = rho & 15; return 8 * (i >> 2) + 4 * n + (i & 3); }

struct Unit { int pm, pn; };
struct Gemm { const bf16_t* A; const bf16_t* Bt; int M, N, K; };

struct StaticOrder {
    int nM, nN, nwg, G, c;
    __host__ __device__ void init(int M, int N, int G_, int c_) { nM = M / BM; nN = N / BM; nwg = nM * nN; G = G_; c = c_; }
    __host__ __device__ bool next(int i, Unit& u) const {
        const long L = (long)i * G + c; if (L >= nwg) return false;
        int wgid = (int)L; { const int q = nwg / NXCD, r = nwg % NXCD, xcd = wgid % NXCD, off = wgid / NXCD; wgid = (xcd < r ? xcd * (q + 1) : r * (q + 1) + (xcd - r) * q) + off; }
        const int nig = WGM * nN, gid = wgid / nig, fm = gid * WGM, gsz = (nM - fm) < WGM ? (nM - fm) : WGM;
        u.pm = fm + ((wgid % nig) % gsz); u.pn = (wgid % nig) / gsz; return true;
    }
    __device__ __forceinline__ void a_ready(const Unit&) const {}
    __device__ __forceinline__ void done(const Unit&) const {}
};
__device__ __forceinline__ unsigned cvt_pk_bf16(float lo, float hi) { unsigned r; asm volatile("v_cvt_pk_bf16_f32 %0, %1, %2" : "=v"(r) : "v"(lo), "v"(hi)); return r; }
typedef float f32x2 __attribute__((ext_vector_type(2)));
template <class Epi, class Sched, bool STAMP = false>
__device__ __forceinline__ void gemm_phase(PG8_LAS unsigned char* lds, const Gemm g, const Sched& S, const Epi& E, unsigned long long* stamps) {
    const int tid = threadIdx.x, wid = __builtin_amdgcn_readfirstlane(tid >> 6), lane = tid & 63, wr = wid >> 2, wc = wid & 3, fr = lane & 15, fq = lane >> 4;
    const int K = g.K, nt = K / BK;
    int ts_lo = 0, ts_hi = 0, nts = 0; const unsigned long long rt_entry = STAMP ? (unsigned long long)wall_clock64() : 0ull;
#define PG8_STAMP() do { if (STAMP && wid == 0 && nts < 64) { const unsigned long long _c = (unsigned long long)clock64(); \
        ts_lo = (lane == nts) ? (int)(unsigned)_c : ts_lo; ts_hi = (lane == nts) ? (int)(unsigned)(_c >> 32) : ts_hi; ++nts; } } while (0)
    PG8_STAMP();
    unsigned voffA[2], voffB[2];
#pragma unroll
    for (int i = 0; i < 2; ++i) { int R, C; stage_rc(tid * 16 + i * 8192, R, C); const int Rb = Epi::PERM ? ((R & ~31) + perm32(R & 31)) : R;
        voffA[i] = (unsigned)(R * K + C) * 2u; voffB[i] = (unsigned)(Rb * K + C) * 2u; }
    const size_t kstep = (size_t)(BK * 2);
    const size_t hstep = (size_t)HALF * K * 2;
    const size_t tstep = 2 * hstep;
    const unsigned ldsw = (unsigned)wid * 1024u;
    const int aoff = lds_byte(wr * 64 + fr, fq * 8), boff = lds_byte(wc * 32 + fr, fq * 8);
#define PG8_SA(b, h) (((b) * 2 + (h)) * HTB)
#define PG8_SB(b, h) ((4 + (b) * 2 + (h)) * HTB)
#define PG8_STAGE(bufoff, gbase, voff) do { _Pragma("unroll") for (int _i = 0; _i < 2; ++_i) \
        __builtin_amdgcn_global_load_lds((const unsigned*)((const char*)(gbase) + (voff)[_i]), (PG8_LAS unsigned*)(lds + (bufoff) + ldsw + _i * 8192), 16, 0, 0); } while (0)
#define PG8_LDA(dst, b, h) do { _Pragma("unroll") for (int m = 0; m < 4; ++m) _Pragma("unroll") for (int k = 0; k < 2; ++k) dst[m][k] = *(const PG8_LAS bf16x8*)(lds + PG8_SA(b, h) + aoff + m * 2048 + k * 1024); } while (0)
#define PG8_LDB(dst, b, h) do { _Pragma("unroll") for (int n = 0; n < 2; ++n) _Pragma("unroll") for (int k = 0; k < 2; ++k) dst[n][k] = *(const PG8_LAS bf16x8*)(lds + PG8_SB(b, h) + boff + n * 2048 + k * 1024); } while (0)
#define PG8_MMA(ai, bj, At, Bt) do { __builtin_amdgcn_s_setprio(1); _Pragma("unroll") for (int m = 0; m < 4; ++m) _Pragma("unroll") for (int n = 0; n < 2; ++n) _Pragma("unroll") for (int k = 0; k < 2; ++k) \
        acc[ai][bj][m][n] = __builtin_amdgcn_mfma_f32_16x16x32_bf16(Bt[n][k], At[m][k], acc[ai][bj][m][n], 0, 0, 0); __builtin_amdgcn_s_setprio(0); } while (0)
#define PG8_WAIT_V(n) asm volatile("s_waitcnt vmcnt(" #n ")" ::: "memory")
#define PG8_WAIT_L(n) asm volatile("s_waitcnt lgkmcnt(" #n ")" ::: "memory")
#define PG8_BAR __builtin_amdgcn_s_barrier()
#define PG8_SCHED __builtin_amdgcn_sched_barrier(0)
    Unit cur, nxt; int ui = 0;
    if (!S.next(0, cur)) return;
    f32x4 acc[2][2][4][2];
#pragma unroll
    for (int a = 0; a < 2; ++a)
#pragma unroll
        for (int b = 0; b < 2; ++b)
#pragma unroll
            for (int m = 0; m < 4; ++m)
#pragma unroll
                for (int n = 0; n < 2; ++n) acc[a][b][m][n] = (f32x4){0.f, 0.f, 0.f, 0.f};
    bf16x8 At[4][2], B0[2][2], B1[2][2];
    const char* cA = (const char*)g.A + (size_t)cur.pm * tstep; const char* cB = (const char*)g.Bt + (size_t)cur.pn * tstep;
    S.a_ready(cur);
    PG8_STAGE(PG8_SB(0, 0), cB, voffB); PG8_STAGE(PG8_SA(0, 0), cA, voffA); PG8_STAGE(PG8_SB(0, 1), cB + hstep, voffB); PG8_STAGE(PG8_SA(0, 1), cA + hstep, voffA);
    if (wr == 1) PG8_BAR;
    PG8_WAIT_V(4); PG8_BAR;
    PG8_STAGE(PG8_SB(1, 0), cB + kstep, voffB); PG8_STAGE(PG8_SA(1, 0), cA + kstep, voffA); PG8_STAGE(PG8_SB(1, 1), cB + hstep + kstep, voffB);
    PG8_WAIT_V(6); PG8_BAR;
    PG8_STAMP();
    for (;;) {
        const bool has_next = S.next(ui + 1, nxt);
        const char* nA = has_next ? (const char*)g.A + (size_t)nxt.pm * tstep : cA; const char* nB = has_next ? (const char*)g.Bt + (size_t)nxt.pn * tstep : cB;
        for (int t = 0; t < nt; t += 2) {
            const bool last = (t == nt - 2);
            const char* a1 = cA + (size_t)(t + 1) * kstep;
            const char* a2 = last ? nA : cA + (size_t)(t + 2) * kstep; const char* b2 = last ? nB : cB + (size_t)(t + 2) * kstep;
            const char* a3 = a2 + kstep; const char* b3 = b2 + kstep;
            if (last && has_next) S.a_ready(nxt);
            PG8_LDB(B0, 0, 0); PG8_SCHED; PG8_LDA(At, 0, 0); PG8_STAGE(PG8_SA(1, 1), a1 + hstep, voffA);
            PG8_WAIT_L(8); PG8_BAR; PG8_WAIT_L(0); PG8_MMA(0, 0, At, B0); PG8_BAR; PG8_SCHED;
            PG8_LDB(B1, 0, 1); PG8_STAGE(PG8_SB(0, 0), b2, voffB);
            PG8_BAR; PG8_WAIT_L(0); PG8_MMA(0, 1, At, B1); PG8_BAR;
            PG8_LDA(At, 0, 1); PG8_STAGE(PG8_SA(0, 0), a2, voffA);
            PG8_BAR; PG8_WAIT_L(0); PG8_MMA(1, 0, At, B0); PG8_BAR; PG8_SCHED;
            PG8_STAGE(PG8_SB(0, 1), b2 + hstep, voffB);
            PG8_WAIT_V(6); PG8_BAR; PG8_MMA(1, 1, At, B1); PG8_BAR;
            PG8_LDB(B0, 1, 0); PG8_SCHED; PG8_LDA(At, 1, 0); PG8_STAGE(PG8_SA(0, 1), a2 + hstep, voffA);
            PG8_WAIT_L(8); PG8_BAR; PG8_WAIT_L(0); PG8_MMA(0, 0, At, B0); PG8_BAR; PG8_SCHED;
            PG8_LDB(B1, 1, 1); PG8_STAGE(PG8_SB(1, 0), b3, voffB);
            PG8_BAR; PG8_WAIT_L(0); PG8_MMA(0, 1, At, B1); PG8_BAR;
            PG8_LDA(At, 1, 1); PG8_STAGE(PG8_SA(1, 0), a3, voffA);
            PG8_BAR; PG8_WAIT_L(0); PG8_MMA(1, 0, At, B0); PG8_BAR; PG8_SCHED;
            PG8_STAGE(PG8_SB(1, 1), b3 + hstep, voffB);
            PG8_WAIT_V(6); PG8_BAR; PG8_MMA(1, 1, At, B1); PG8_BAR;
        }
        PG8_STAMP();
        if constexpr (!Epi::AFTER_DRAIN) { E(acc, cur, wr, wc, fr, fq); S.done(cur); }
        PG8_STAMP();
        if (!has_next) break;
#pragma unroll
        for (int a = 0; a < 2; ++a)
#pragma unroll
            for (int b = 0; b < 2; ++b)
#pragma unroll
                for (int m = 0; m < 4; ++m)
#pragma unroll
                    for (int n = 0; n < 2; ++n) acc[a][b][m][n] = (f32x4){0.f, 0.f, 0.f, 0.f};
        cur = nxt; cA = nA; cB = nB; ++ui;
    }
    PG8_WAIT_V(0);
    if (wr == 0) PG8_BAR;
    PG8_BAR;
    if constexpr (Epi::AFTER_DRAIN) { E.fused(acc, cur, wr, wc, fr, fq, lds, wid, lane); S.done(cur); }
    PG8_STAMP();
    if (STAMP && wid == 0) { stamps[lane] = lane < nts ? (((unsigned long long)(unsigned)ts_hi << 32) | (unsigned)ts_lo) : 0ull;
        if (lane == 62) stamps[62] = rt_entry; if (lane == 63) stamps[63] = (unsigned long long)wall_clock64(); }
#undef PG8_STAMP
#undef PG8_SA
#undef PG8_SB
#undef PG8_STAGE
#undef PG8_LDA
#undef PG8_LDB
#undef PG8_MMA
#undef PG8_WAIT_V
#undef PG8_WAIT_L
#undef PG8_BAR
#undef PG8_SCHED
}
}

namespace cg = cooperative_groups;
typedef unsigned short bf16_t;
typedef short bf16x8 __attribute__((ext_vector_type(8)));
typedef short bf16x4 __attribute__((ext_vector_type(4)));
typedef float f32x4 __attribute__((ext_vector_type(4)));
typedef unsigned u32x4 __attribute__((ext_vector_type(4)));
typedef unsigned u32x2 __attribute__((ext_vector_type(2)));

constexpr int TP = 65536, TS = 512, TT = TP + TS;
constexpr int DM = 1024;
constexpr int NTHR = 512;
constexpr int LDS_BYTES = 131072;
constexpr int NIN = 7936;
constexpr int IN_W = 9760;

constexpr size_t O_YP = 0, O_YS = 67108864, O_KP = 67633152, O_VP = 67895296, O_CP = 68157440, O_SP = 68231168,
                 O_KS = 70328320, O_VS = 70459392, O_CS = 70590464, O_SS = 70737920;
constexpr size_t SZ1K = (size_t)TT * 1024 * 2;
constexpr size_t W_Q = 0, W_K = W_Q + SZ1K, W_V = W_K + SZ1K / 4, W_G = W_V + SZ1K / 4, W_Z = W_G + SZ1K, W_XBC = W_Z + 2 * SZ1K,
                 W_DT = W_XBC + 3 * SZ1K, W_WIN = W_DT + (size_t)TT * 32 * 4, W_WG = W_WIN + (size_t)NIN * 1024 * 2, W_WAO = W_WG + 2048 * 1024 * 2,
                 W_WSO = W_WAO + 1024 * 1024 * 2, W_WOUT = W_WSO + 1024 * 2048 * 2, W_ROPE = W_WOUT + 1024 * 1024 * 2,
                 W_SSQG = W_ROPE + 8224 * 8 * 8, W_SSQO = W_SSQG + (size_t)TT * 32 * 4, W_BAR = W_SSQO + (size_t)TT * 16 * 4, W_END = W_BAR + 1024;
constexpr size_t W_GA = W_XBC, W_GS = W_XBC + SZ1K, W_MG = W_XBC + 2 * SZ1K;
static_assert(W_END <= (size_t)1073741824, "workspace");

struct Params {
    const float *x_prompt, *x_sample, *cache_k, *cache_v, *state_conv, *state_ssm, *pre_norm_w, *w_in, *conv_w, *conv_b, *dt_bias, *a_log, *d_skip,
        *sinks, *ssm_norm_w, *w_attn_o, *w_ssm_o, *w_out, *post_norm_w;
    float* out; unsigned char* ws; int ph_lo, ph_hi; unsigned long long ws_size; int dbg, pad;
};

__device__ __forceinline__ unsigned short f2bf(float f) { unsigned u = __float_as_uint(f); u += 0x7FFFu + ((u >> 16) & 1u); return (unsigned short)(u >> 16); }
__device__ __forceinline__ float bf2f(unsigned short b) { return __uint_as_float(((unsigned)b) << 16); }
__device__ __forceinline__ float bf2f_s(short b) { return __uint_as_float(((unsigned)(unsigned short)b) << 16); }
__device__ __forceinline__ unsigned pk2(float lo, float hi) { return pg8::cvt_pk_bf16(lo, hi); }
__device__ __forceinline__ float sigmoidf_(float x) { return 1.0f / (1.0f + __expf(-x)); }
__device__ __forceinline__ float siluf_(float x) { return x / (1.0f + __expf(-x)); }
__device__ __forceinline__ void unpack8(const u32x4 w, float (&v)[8]) {
    v[0] = __uint_as_float(w.x << 16); v[1] = __uint_as_float(w.x & 0xffff0000u); v[2] = __uint_as_float(w.y << 16); v[3] = __uint_as_float(w.y & 0xffff0000u);
    v[4] = __uint_as_float(w.z << 16); v[5] = __uint_as_float(w.z & 0xffff0000u); v[6] = __uint_as_float(w.w << 16); v[7] = __uint_as_float(w.w & 0xffff0000u);
}
__device__ __forceinline__ u32x4 pack8(const float (&v)[8]) { u32x4 w; w.x = pk2(v[0], v[1]); w.y = pk2(v[2], v[3]); w.z = pk2(v[4], v[5]); w.w = pk2(v[6], v[7]); return w; }

__device__ __forceinline__ void transpose_tile(unsigned char* lds, const float* src, int ld, int col0, int ncols_valid, int k0, bf16_t* dst, int dstK, int n0, const float* kscale) {
    float* tile = (float*)lds;
    const int tid = threadIdx.x;
    const int kk = tid >> 4, c4 = (tid & 15) * 4;
#pragma unroll
    for (int pass = 0; pass < 2; ++pass) {
        const int k = kk + pass * 32;
        float4 v = make_float4(0.f, 0.f, 0.f, 0.f);
        if (c4 < ncols_valid) v = *(const float4*)(src + (size_t)(k0 + k) * ld + col0 + c4);
        if (kscale) { const float s = kscale[k0 + k]; v.x *= s; v.y *= s; v.z *= s; v.w *= s; }
        tile[k * 65 + c4 + 0] = v.x; tile[k * 65 + c4 + 1] = v.y; tile[k * 65 + c4 + 2] = v.z; tile[k * 65 + c4 + 3] = v.w;
    }
    __syncthreads();
    const int n = tid >> 3, kg = tid & 7;
    float v[8];
#pragma unroll
    for (int j = 0; j < 8; ++j) v[j] = tile[(kg * 8 + j) * 65 + n];
    *(u32x4*)(dst + (size_t)(n0 + n) * dstK + k0 + kg * 8) = pack8(v);
    __syncthreads();
}

__device__ void p0_prologue(const Params& p, unsigned char* lds) {
    const int tid = threadIdx.x, lane = tid & 63, wave = tid >> 6;
    const int G = gridDim.x, bid = blockIdx.x;
    bf16_t* H = (bf16_t*)p.out;
    for (int t = bid * 8 + wave; t < TT; t += G * 8) {
        const float* xr = t < TP ? p.x_prompt + (size_t)t * DM : p.x_sample + (size_t)(t - TP) * DM;
        float4 v[4]; float ss = 0.f;
#pragma unroll
        for (int i = 0; i < 4; ++i) { v[i] = *(const float4*)(xr + i * 256 + lane * 4); ss += v[i].x * v[i].x + v[i].y * v[i].y + v[i].z * v[i].z + v[i].w * v[i].w; }
#pragma unroll
        for (int o = 32; o >= 1; o >>= 1) ss += __shfl_xor(ss, o);
        const float r = rsqrtf(ss * (1.0f / 1024.0f) + 1e-6f);
#pragma unroll
        for (int i = 0; i < 4; ++i) { const float4 w = *(const float4*)(p.pre_norm_w + i * 256 + lane * 4);
            u32x2 o; o.x = pk2(v[i].x * r * w.x, v[i].y * r * w.y); o.y = pk2(v[i].z * r * w.z, v[i].w * r * w.w);
            *(u32x2*)(H + (size_t)t * DM + i * 256 + lane * 4) = o; }
    }
    bf16_t* WIN = (bf16_t*)(p.ws + W_WIN); bf16_t* WG = (bf16_t*)(p.ws + W_WG); bf16_t* WAO = (bf16_t*)(p.ws + W_WAO);
    bf16_t* WSO = (bf16_t*)(p.ws + W_WSO); bf16_t* WOUT = (bf16_t*)(p.ws + W_WOUT);
    constexpr int J0 = 1920, J1 = J0 + 16, J2 = J1 + 512, J3 = J2 + 256, J4 = J3 + 512, J5 = J4 + 256;
    for (int j = bid; j < J5; j += G) {
        if (j < J0) { const int nt = j >> 4, kt = j & 15; transpose_tile(lds, p.w_in, IN_W, nt * 64, 64, kt * 64, WIN, 1024, nt * 64, nullptr); }
        else if (j < J1) { const int kt = j - J0; transpose_tile(lds, p.w_in, IN_W, 7680, 32, kt * 64, WIN, 1024, 7680, nullptr); }
        else if (j < J2) { const int jj = j - J1, nt = jj >> 4, kt = jj & 15; transpose_tile(lds, p.w_in, IN_W, 7712 + nt * 64, 64, kt * 64, WG, 1024, nt * 64, nullptr); }
        else if (j < J3) { const int jj = j - J2, nt = jj >> 4, kt = jj & 15; transpose_tile(lds, p.w_attn_o, 1024, nt * 64, 64, kt * 64, WAO, 1024, nt * 64, nullptr); }
        else if (j < J4) { const int jj = j - J3, nt = jj >> 5, kt = jj & 31; transpose_tile(lds, p.w_ssm_o, 1024, nt * 64, 64, kt * 64, WSO, 2048, nt * 64, p.ssm_norm_w); }
        else { const int jj = j - J4, nt = jj >> 4, kt = jj & 15; transpose_tile(lds, p.w_out, 1024, nt * 64, 64, kt * 64, WOUT, 1024, nt * 64, nullptr); }
    }
    const size_t gtid = (size_t)bid * NTHR + tid, gstride = (size_t)G * NTHR;
    { u32x4* z = (u32x4*)(WIN + (size_t)7744 * 1024); const size_t n16 = (size_t)192 * 1024 * 2 / 16; const u32x4 zero = {0u, 0u, 0u, 0u};
      for (size_t i = gtid; i < n16; i += gstride) z[i] = zero; }
    { float2* rope = (float2*)(p.ws + W_ROPE);
      for (size_t i = gtid; i < 8224 * 8; i += gstride) { const int pi = (int)(i >> 3), j = (int)(i & 7); const int pos = pi < 8192 ? pi : 2048 + (pi - 8192);
          const float inv = (float)pow(500000.0, -(double)j / 8.0); const float ang = (float)pos * inv; double s, c; sincos((double)ang, &s, &c); rope[i] = make_float2((float)c, (float)s); } }
}

struct EpiInProj {
    static constexpr bool PERM = true, AFTER_DRAIN = false;
    unsigned char* ws; const float* dt_bias;
    __device__ __forceinline__ void operator()(const f32x4 (&acc)[2][2][4][2], const pg8::Unit& u, int wr, int wc, int fr, int fq) const {
        const int pn = u.pn; const int row0 = u.pm * 256 + wr * 64 + fr;
        if (pn == 30) {
            if (wc == 0) { float* DT = (float*)(ws + W_DT);
#pragma unroll
                for (int n = 0; n < 2; ++n) { const f32x4 bv = *(const f32x4*)(dt_bias + 8 * fq + 4 * n);
#pragma unroll
                    for (int ai = 0; ai < 2; ++ai)
#pragma unroll
                        for (int m = 0; m < 4; ++m) { f32x4 v = acc[ai][0][m][n] + bv;
#pragma unroll
                            for (int j = 0; j < 4; ++j) v[j] = v[j] > 20.f ? v[j] : log1pf(__expf(v[j]));
                            *(f32x4*)(DT + (size_t)(row0 + ai * 128 + m * 16) * 32 + 8 * fq + 4 * n) = v; } } }
            return;
        }
        bf16_t* base; int ldc, colt;
        if (pn < 4) { base = (bf16_t*)(ws + W_Q); ldc = 1024; colt = pn * 256; }
        else if (pn == 4) { base = (bf16_t*)(ws + W_K); ldc = 256; colt = 0; }
        else if (pn == 5) { base = (bf16_t*)(ws + W_V); ldc = 256; colt = 0; }
        else if (pn < 10) { base = (bf16_t*)(ws + W_G); ldc = 1024; colt = (pn - 6) * 256; }
        else if (pn < 18) { base = (bf16_t*)(ws + W_Z); ldc = 2048; colt = (pn - 10) * 256; }
        else { base = (bf16_t*)(ws + W_XBC); ldc = 3072; colt = (pn - 18) * 256; }
        const int col0 = colt + wc * 32 + 8 * fq;
#pragma unroll
        for (int ai = 0; ai < 2; ++ai)
#pragma unroll
            for (int m = 0; m < 4; ++m) { bf16_t* rowp = base + (size_t)(row0 + ai * 128 + m * 16) * ldc + col0;
#pragma unroll
                for (int bj = 0; bj < 2; ++bj) { const f32x4 v0 = acc[ai][bj][m][0], v1 = acc[ai][bj][m][1];
                    u32x4 w; w.x = pk2(v0[0], v0[1]); w.y = pk2(v0[2], v0[3]); w.z = pk2(v1[0], v1[1]); w.w = pk2(v1[2], v1[3]);
                    *(u32x4*)(rowp + bj * 128) = w; } }
    }
};
template <int MODE> struct EpiMerge {
    static constexpr bool PERM = true, AFTER_DRAIN = false;
    bf16_t* O; const bf16_t* G1;
    __device__ __forceinline__ void operator()(const f32x4 (&acc)[2][2][4][2], const pg8::Unit& u, int wr, int wc, int fr, int fq) const {
        const int row0 = u.pm * 256 + wr * 64 + fr; const int col0 = u.pn * 256 + wc * 32 + 8 * fq;
#pragma unroll
        for (int ai = 0; ai < 2; ++ai)
#pragma unroll
            for (int m = 0; m < 4; ++m) { const size_t off = (size_t)(row0 + ai * 128 + m * 16) * 1024 + col0;
#pragma unroll
                for (int bj = 0; bj < 2; ++bj) { const f32x4 v0 = acc[ai][bj][m][0], v1 = acc[ai][bj][m][1];
                    float v[8] = {v0[0], v0[1], v0[2], v0[3], v1[0], v1[1], v1[2], v1[3]};
                    if (MODE == 0) {
#pragma unroll
                        for (int j = 0; j < 8; ++j) v[j] = sigmoidf_(v[j]);
                    } else { float g[8]; unpack8(*(const u32x4*)(G1 + off + bj * 128), g);
                        if (MODE == 1) {
#pragma unroll
                            for (int j = 0; j < 8; ++j) v[j] = g[j] * v[j];
                        } else { float o[8]; unpack8(*(const u32x4*)(O + off + bj * 128), o);
#pragma unroll
                            for (int j = 0; j < 8; ++j) v[j] = o[j] + g[j] * v[j]; } }
                    *(u32x4*)(O + off + bj * 128) = pack8(v); } }
    }
};
struct EpiOut {
    static constexpr bool PERM = true, AFTER_DRAIN = false;
    float* out; float* ssq;
    __device__ __forceinline__ void operator()(const f32x4 (&acc)[2][2][4][2], const pg8::Unit& u, int wr, int wc, int fr, int fq) const {
        const int row0 = u.pm * 256 + wr * 64 + fr, col0 = u.pn * 256 + wc * 32 + 8 * fq;
#pragma unroll
        for (int ai = 0; ai < 2; ++ai)
#pragma unroll
            for (int m = 0; m < 4; ++m) { const int row = row0 + ai * 128 + m * 16; float* rowp = out + (size_t)row * 1024 + col0;
                float s = 0.f;
#pragma unroll
                for (int bj = 0; bj < 2; ++bj)
#pragma unroll
                    for (int n = 0; n < 2; ++n) { const f32x4 x = acc[ai][bj][m][n]; *(f32x4*)(rowp + bj * 128 + n * 4) = x; s += x[0] * x[0] + x[1] * x[1] + x[2] * x[2] + x[3] * x[3]; }
                s += __shfl_xor(s, 16); s += __shfl_xor(s, 32);
                if (fq == 0) ssq[(size_t)row * 16 + u.pn * 4 + wc] = s; }
    }
};

constexpr int KS_STRIDE = 72;
constexpr int VT_STRIDE = 200;
constexpr int KS_OFF = 0, VT_OFF = 192 * KS_STRIDE * 2;

__device__ void attn_unit(const Params& p, unsigned char* lds, const int is_sample, const int b, const int c, const int kvh) {
    const int tid = threadIdx.x, lane = tid & 63, wave = tid >> 6, fr = lane & 15, fq = lane >> 4;
    bf16_t* Q = (bf16_t*)(p.ws + W_Q); const bf16_t* K = (const bf16_t*)(p.ws + W_K); const bf16_t* V = (const bf16_t*)(p.ws + W_V);
    const bf16_t* GT = (const bf16_t*)(p.ws + W_G); const float2* rope = (const float2*)(p.ws + W_ROPE);
    bf16_t* Ks = (bf16_t*)(lds + KS_OFF); bf16_t* Vt = (bf16_t*)(lds + VT_OFF);
    int nkeys, ncache, NQ, cs; size_t tq0, tk0; int pos_q0, pos_k0;
    if (is_sample) { nkeys = 160; ncache = 128; NQ = 32; cs = 0; tq0 = (size_t)TP + b * 32; tk0 = tq0; pos_q0 = 8192; pos_k0 = 8192; }
    else { cs = c >= 2 ? c - 2 : 0; nkeys = (c - cs + 1) * 64; ncache = 0; NQ = 64; tq0 = (size_t)b * 8192 + c * 64; tk0 = (size_t)b * 8192 + cs * 64; pos_q0 = c * 64; pos_k0 = cs * 64; }
    __syncthreads();
    for (int item = tid; item < nkeys * 4; item += NTHR) {
        const int key = item >> 2, i = item & 3;
        float v[16];
        if (key < ncache) { const float* src = p.cache_k + ((size_t)(b * 128 + key) * 4 + kvh) * 64 + i * 16;
#pragma unroll
            for (int q4 = 0; q4 < 4; ++q4) { const float4 f = *(const float4*)(src + q4 * 4); v[q4 * 4] = f.x; v[q4 * 4 + 1] = f.y; v[q4 * 4 + 2] = f.z; v[q4 * 4 + 3] = f.w; }
        } else {
            const int kk = key - ncache; const bf16_t* src = K + (tk0 + kk) * 256 + kvh * 64 + i * 16;
            float a[8], bb[8]; unpack8(*(const u32x4*)src, a); unpack8(*(const u32x4*)(src + 8), bb);
            if (i == 0) { const float2* rp = rope + (size_t)(pos_k0 + kk) * 8;
#pragma unroll
                for (int j = 0; j < 8; ++j) { const float2 cssn = rp[j]; v[j] = a[j] * cssn.x - bb[j] * cssn.y; v[8 + j] = bb[j] * cssn.x + a[j] * cssn.y; }
            } else {
#pragma unroll
                for (int j = 0; j < 8; ++j) { v[j] = a[j]; v[8 + j] = bb[j]; } }
            float* dst = nullptr;
            if (is_sample) dst = p.out + O_KS + ((size_t)(b * 32 + kk) * 4 + kvh) * 64 + i * 16;
            else if (c >= 126 && kk >= (c - cs) * 64) dst = p.out + O_KP + ((size_t)(b * 128 + (c - 126) * 64 + (kk - (c - cs) * 64)) * 4 + kvh) * 64 + i * 16;
            if (dst) {
#pragma unroll
                for (int q4 = 0; q4 < 4; ++q4) *(float4*)(dst + q4 * 4) = make_float4(v[q4 * 4], v[q4 * 4 + 1], v[q4 * 4 + 2], v[q4 * 4 + 3]); }
        }
        float lo[8], hi[8];
#pragma unroll
        for (int j = 0; j < 8; ++j) { lo[j] = v[j]; hi[j] = v[8 + j]; }
        *(u32x4*)(Ks + key * KS_STRIDE + i * 16) = pack8(lo); *(u32x4*)(Ks + key * KS_STRIDE + i * 16 + 8) = pack8(hi);
    }
    for (int item = tid; item < nkeys * 8; item += NTHR) {
        const int dg = item / nkeys, key = item - dg * nkeys;
        float v[8];
        if (key < ncache) { const float* src = p.cache_v + ((size_t)(b * 128 + key) * 4 + kvh) * 64 + dg * 8;
            const float4 f0 = *(const float4*)src, f1 = *(const float4*)(src + 4); v[0] = f0.x; v[1] = f0.y; v[2] = f0.z; v[3] = f0.w; v[4] = f1.x; v[5] = f1.y; v[6] = f1.z; v[7] = f1.w;
        } else {
            const int kk = key - ncache; unpack8(*(const u32x4*)(V + (tk0 + kk) * 256 + kvh * 64 + dg * 8), v);
            float* dst = nullptr;
            if (is_sample) dst = p.out + O_VS + ((size_t)(b * 32 + kk) * 4 + kvh) * 64 + dg * 8;
            else if (c >= 126 && kk >= (c - cs) * 64) dst = p.out + O_VP + ((size_t)(b * 128 + (c - 126) * 64 + (kk - (c - cs) * 64)) * 4 + kvh) * 64 + dg * 8;
            if (dst) { *(float4*)dst = make_float4(v[0], v[1], v[2], v[3]); *(float4*)(dst + 4) = make_float4(v[4], v[5], v[6], v[7]); }
        }
#pragma unroll
        for (int e = 0; e < 8; ++e) Vt[(dg * 8 + e) * VT_STRIDE + key] = f2bf(v[e]);
    }
    __syncthreads();
    const int nqt_h = NQ >> 4, nqt = 4 * nqt_h, nkt = nkeys >> 4;
    for (int qt = wave; qt < nqt; qt += 8) {
        const int g = qt / nqt_h, r0 = (qt - g * nqt_h) * 16, hq = kvh * 4 + g;
        bf16_t* qp = Q + (tq0 + r0 + fr) * 1024 + hq * 64 + fq * 8;
        bf16x8 q0 = *(const bf16x8*)qp, q1 = *(const bf16x8*)(qp + 32);
        { const float2* rp = rope + (size_t)(pos_q0 + r0 + fr) * 8;
#pragma unroll
          for (int j = 0; j < 8; ++j) { const float mine = bf2f_s(q0[j]); const float other = __shfl_xor(mine, 16); const float2 cssn = rp[j];
              const float nv = (fq == 0) ? mine * cssn.x - other * cssn.y : mine * cssn.x + other * cssn.y;
              if (fq < 2) q0[j] = (short)f2bf(nv); } }
        f32x4 sacc[12];
#pragma unroll
        for (int kt = 0; kt < 12; ++kt) { sacc[kt] = (f32x4){0.f, 0.f, 0.f, 0.f};
            if (kt < nkt) { const bf16_t* kp = Ks + (kt * 16 + fr) * KS_STRIDE + fq * 8;
                sacc[kt] = __builtin_amdgcn_mfma_f32_16x16x32_bf16(*(const bf16x8*)kp, q0, sacc[kt], 0, 0, 0);
                sacc[kt] = __builtin_amdgcn_mfma_f32_16x16x32_bf16(*(const bf16x8*)(kp + 32), q1, sacc[kt], 0, 0, 0); } }
        const float sk = p.sinks[hq];
        float m = sk;
#pragma unroll
        for (int kt = 0; kt < 12; ++kt) if (kt < nkt) {
#pragma unroll
            for (int r = 0; r < 4; ++r) { sacc[kt][r] *= 0.125f; m = fmaxf(m, sacc[kt][r]); } }
        m = fmaxf(m, __shfl_xor(m, 16)); m = fmaxf(m, __shfl_xor(m, 32));
        float sum = 0.f;
#pragma unroll
        for (int kt = 0; kt < 12; ++kt) if (kt < nkt) {
#pragma unroll
            for (int r = 0; r < 4; ++r) { const float e = __expf(sacc[kt][r] - m); sacc[kt][r] = e; sum += e; } }
        sum += __shfl_xor(sum, 16); sum += __shfl_xor(sum, 32);
        const float inv = 1.0f / (sum + __expf(sk - m));
        f32x4 oacc[4];
#pragma unroll
        for (int dt = 0; dt < 4; ++dt) oacc[dt] = (f32x4){0.f, 0.f, 0.f, 0.f};
#pragma unroll
        for (int kk = 0; kk < 6; ++kk) if (2 * kk < nkt) {
            union { bf16x8 v; unsigned u[4]; } pb;
            pb.u[0] = pk2(sacc[2 * kk][0], sacc[2 * kk][1]); pb.u[1] = pk2(sacc[2 * kk][2], sacc[2 * kk][3]);
            pb.u[2] = pk2(sacc[2 * kk + 1][0], sacc[2 * kk + 1][1]); pb.u[3] = pk2(sacc[2 * kk + 1][2], sacc[2 * kk + 1][3]);
#pragma unroll
            for (int dt = 0; dt < 4; ++dt) { const bf16_t* vp = Vt + (dt * 16 + fr) * VT_STRIDE + kk * 32 + fq * 4;
                union { bf16x8 v; u32x2 h[2]; } va; va.h[0] = *(const u32x2*)vp; va.h[1] = *(const u32x2*)(vp + 16);
                oacc[dt] = __builtin_amdgcn_mfma_f32_16x16x32_bf16(va.v, pb.v, oacc[dt], 0, 0, 0); } }
#pragma unroll
        for (int dt = 0; dt < 4; ++dt) { const size_t off = (tq0 + r0 + fr) * 1024 + hq * 64 + dt * 16 + fq * 4;
            const u32x2 gw = *(const u32x2*)(GT + off);
            const float g0 = __uint_as_float(gw.x << 16), g1 = __uint_as_float(gw.x & 0xffff0000u), g2 = __uint_as_float(gw.y << 16), g3 = __uint_as_float(gw.y & 0xffff0000u);
            u32x2 o; o.x = pk2(oacc[dt][0] * inv * siluf_(g0), oacc[dt][1] * inv * siluf_(g1)); o.y = pk2(oacc[dt][2] * inv * siluf_(g2), oacc[dt][3] * inv * siluf_(g3));
            *(u32x2*)(Q + off) = o; }
    }
}

constexpr int CS_OFF = 0, BS_OFF = 17408, BT_OFF = 34816, XT_OFF = 53248, XTS_OFF = 62464, MS_OFF = 71680, HS_OFF = 80896, YS_OFF = 98304, SC_OFF = 115712, CW_OFF = 116736;
constexpr int ST136 = 136, ST72 = 72, YS_ST = 68;

__device__ __forceinline__ void conv8(float (&v)[8], const bf16_t* XBC, const size_t tseq0, const int s, const int gch, const float* cw, const int l0, const float* sconv) {
    { const float4 b0 = *(const float4*)(cw + 4 * 320 + l0), b1 = *(const float4*)(cw + 4 * 320 + l0 + 4);
      v[0] = b0.x; v[1] = b0.y; v[2] = b0.z; v[3] = b0.w; v[4] = b1.x; v[5] = b1.y; v[6] = b1.z; v[7] = b1.w; }
#pragma unroll
    for (int tap = 0; tap < 4; ++tap) {
        const int xi = s + tap - 3;
        float xv[8];
        if (xi >= 0) unpack8(*(const u32x4*)(XBC + (tseq0 + xi) * 3072 + gch), xv);
        else if (sconv) { const float* sp = sconv + (xi + 3) * 3072 + gch; const float4 a = *(const float4*)sp, bb = *(const float4*)(sp + 4);
            xv[0] = a.x; xv[1] = a.y; xv[2] = a.z; xv[3] = a.w; xv[4] = bb.x; xv[5] = bb.y; xv[6] = bb.z; xv[7] = bb.w; }
        else {
#pragma unroll
            for (int e = 0; e < 8; ++e) xv[e] = 0.f; }
        const float4 w0 = *(const float4*)(cw + tap * 320 + l0), w1 = *(const float4*)(cw + tap * 320 + l0 + 4);
        v[0] += xv[0] * w0.x; v[1] += xv[1] * w0.y; v[2] += xv[2] * w0.z; v[3] += xv[3] * w0.w; v[4] += xv[4] * w1.x; v[5] += xv[5] * w1.y; v[6] += xv[6] * w1.z; v[7] += xv[7] * w1.w;
    }
#pragma unroll
    for (int e = 0; e < 8; ++e) v[e] = siluf_(v[e]);
}

__device__ void ssd_seq(const Params& p, unsigned char* lds, const int is_sample, const int b, const int h) {
    const int tid = threadIdx.x, lane = tid & 63, wave = tid >> 6, fr = lane & 15, fq = lane >> 4;
    const int g = h >> 3;
    const bf16_t* XBC = (const bf16_t*)(p.ws + W_XBC); bf16_t* Z = (bf16_t*)(p.ws + W_Z); const float* DT = (const float*)(p.ws + W_DT); float* SSQG = (float*)(p.ws + W_SSQG);
    bf16_t* Cs = (bf16_t*)(lds + CS_OFF); bf16_t* Bs = (bf16_t*)(lds + BS_OFF); bf16_t* Bt = (bf16_t*)(lds + BT_OFF); bf16_t* Xt = (bf16_t*)(lds + XT_OFF);
    bf16_t* Xts = (bf16_t*)(lds + XTS_OFF); bf16_t* Ms = (bf16_t*)(lds + MS_OFF); bf16_t* Hs = (bf16_t*)(lds + HS_OFF); float* Ys = (float*)(lds + YS_OFF);
    float* dt_s = (float*)(lds + SC_OFF); float* cum_s = dt_s + 64; float* ecum_s = dt_s + 128; float* toend_s = dt_s + 192; float* cw = (float*)(lds + CW_OFF);
    const int nchunks = is_sample ? 1 : 128, Lc = is_sample ? 32 : 64;
    const size_t tseq0 = is_sample ? (size_t)TP + b * 32 : (size_t)b * 8192;
    const float* sconv = is_sample ? p.state_conv + (size_t)b * 3 * 3072 : nullptr;
    const float a_h = -__expf(p.a_log[h]); const float d_h = p.d_skip[h];
    __syncthreads();
    for (int i = tid; i < 5 * 320; i += NTHR) { const int tap = i / 320, l = i - tap * 320; const int gch = l < 64 ? h * 64 + l : (l < 192 ? 2048 + g * 128 + (l - 64) : 2560 + g * 128 + (l - 192));
        cw[i] = tap < 4 ? p.conv_w[tap * 3072 + gch] : p.conv_b[gch]; }
    const int pt = wave & 3, nt0 = (wave >> 2) * 4;
    f32x4 Hacc[4];
#pragma unroll
    for (int k = 0; k < 4; ++k)
#pragma unroll
        for (int r = 0; r < 4; ++r) Hacc[k][r] = is_sample ? p.state_ssm[((size_t)(b * 32 + h) * 64 + pt * 16 + fq * 4 + r) * 128 + (nt0 + k) * 16 + fr] : 0.f;
    const int it = wave >> 1;
    for (int c = 0; c < nchunks; ++c) {
        const size_t t0 = tseq0 + (size_t)c * 64; const int s0 = c * 64;
        __syncthreads();
        if (wave == 0) {
            const float dtv = lane < Lc ? DT[(t0 + lane) * 32 + h] : 0.f;
            float x = dtv * a_h;
#pragma unroll
            for (int off = 1; off < 64; off <<= 1) { const float y = __shfl_up(x, off); if (lane >= off) x += y; }
            const float cl = __shfl(x, 63);
            dt_s[lane] = dtv; cum_s[lane] = x; ecum_s[lane] = __expf(x); toend_s[lane] = __expf(cl - x) * dtv;
        }
#pragma unroll
        for (int k = 0; k < 4; ++k)
#pragma unroll
            for (int r = 0; r < 4; ++r) Hs[(pt * 16 + fq * 4 + r) * ST136 + (nt0 + k) * 16 + fr] = f2bf(Hacc[k][r]);
#pragma unroll 1
        for (int itx = 0; itx < 4; ++itx) {
            const int item = tid + itx * NTHR, row = item >> 5, cgi = item & 31, l0 = 64 + cgi * 8;
            const int gch = cgi < 16 ? 2048 + g * 128 + cgi * 8 : 2560 + g * 128 + (cgi - 16) * 8;
            float v[8];
            if (row < Lc) conv8(v, XBC, tseq0, s0 + row, gch, cw, l0, sconv);
            else {
#pragma unroll
                for (int e = 0; e < 8; ++e) v[e] = 0.f; }
            const u32x4 w = pack8(v);
            if (cgi < 16) { *(u32x4*)(Bs + row * ST136 + cgi * 8) = w;
#pragma unroll
                for (int e = 0; e < 8; ++e) Bt[(cgi * 8 + e) * ST72 + row] = f2bf(v[e]);
            } else *(u32x4*)(Cs + row * ST136 + (cgi - 16) * 8) = w;
        }
        __syncthreads();
        { const int row = tid >> 3, cg8 = tid & 7; float v[8];
          if (row < Lc) conv8(v, XBC, tseq0, s0 + row, h * 64 + cg8 * 8, cw, cg8 * 8, sconv);
          else {
#pragma unroll
              for (int e = 0; e < 8; ++e) v[e] = 0.f; }
          const float te = toend_s[row];
#pragma unroll
          for (int e = 0; e < 8; ++e) { Xt[(cg8 * 8 + e) * ST72 + row] = f2bf(v[e]); Xts[(cg8 * 8 + e) * ST72 + row] = f2bf(v[e] * te); } }
#pragma unroll
        for (int jj = 0; jj < 2; ++jj) {
            const int jt = (wave & 1) * 2 + jj;
            f32x4 acc = {0.f, 0.f, 0.f, 0.f};
            if (jt <= it) {
#pragma unroll
                for (int ks = 0; ks < 4; ++ks) acc = __builtin_amdgcn_mfma_f32_16x16x32_bf16(*(const bf16x8*)(Cs + (it * 16 + fr) * ST136 + ks * 32 + fq * 8), *(const bf16x8*)(Bs + (jt * 16 + fr) * ST136 + ks * 32 + fq * 8), acc, 0, 0, 0);
            }
            const int j = jt * 16 + fr; const float cj = cum_s[j], dj = dt_s[j];
#pragma unroll
            for (int r = 0; r < 4; ++r) { const int i = it * 16 + fq * 4 + r;
                float val = (jt <= it && j <= i) ? acc[r] * __expf(cum_s[i] - cj) * dj : 0.f;
                if (i == j) val += d_h;
                Ms[i * ST72 + j] = f2bf(val); }
        }
        f32x4 accY[2];
#pragma unroll
        for (int pp = 0; pp < 2; ++pp) { const int ptile = (wave & 1) * 2 + pp; accY[pp] = (f32x4){0.f, 0.f, 0.f, 0.f};
#pragma unroll
            for (int ks = 0; ks < 4; ++ks) accY[pp] = __builtin_amdgcn_mfma_f32_16x16x32_bf16(*(const bf16x8*)(Cs + (it * 16 + fr) * ST136 + ks * 32 + fq * 8), *(const bf16x8*)(Hs + (ptile * 16 + fr) * ST136 + ks * 32 + fq * 8), accY[pp], 0, 0, 0);
#pragma unroll
            for (int r = 0; r < 4; ++r) accY[pp][r] *= ecum_s[it * 16 + fq * 4 + r]; }
        __syncthreads();
#pragma unroll
        for (int pp = 0; pp < 2; ++pp) { const int ptile = (wave & 1) * 2 + pp;
#pragma unroll
            for (int ks = 0; ks < 2; ++ks) if (ks * 32 <= it * 16 + 15)
                accY[pp] = __builtin_amdgcn_mfma_f32_16x16x32_bf16(*(const bf16x8*)(Ms + (it * 16 + fr) * ST72 + ks * 32 + fq * 8), *(const bf16x8*)(Xt + (ptile * 16 + fr) * ST72 + ks * 32 + fq * 8), accY[pp], 0, 0, 0);
#pragma unroll
            for (int r = 0; r < 4; ++r) Ys[(it * 16 + fq * 4 + r) * YS_ST + ptile * 16 + fr] = accY[pp][r]; }
        { const float dec = ecum_s[63];
#pragma unroll
          for (int k = 0; k < 4; ++k) {
#pragma unroll
              for (int r = 0; r < 4; ++r) Hacc[k][r] *= dec;
#pragma unroll
              for (int ks = 0; ks < 2; ++ks) Hacc[k] = __builtin_amdgcn_mfma_f32_16x16x32_bf16(*(const bf16x8*)(Xts + (pt * 16 + fr) * ST72 + ks * 32 + fq * 8), *(const bf16x8*)(Bt + ((nt0 + k) * 16 + fr) * ST72 + ks * 32 + fq * 8), Hacc[k], 0, 0, 0); } }
        __syncthreads();
        { const int row = tid >> 3, pg = tid & 7;
          if (row < Lc) { const float4 y0 = *(const float4*)(Ys + row * YS_ST + pg * 8), y1 = *(const float4*)(Ys + row * YS_ST + pg * 8 + 4);
              bf16_t* zp = Z + (t0 + row) * 2048 + h * 64 + pg * 8; float z[8]; unpack8(*(const u32x4*)zp, z);
              float v[8] = {y0.x, y0.y, y0.z, y0.w, y1.x, y1.y, y1.z, y1.w}; float ss = 0.f;
#pragma unroll
              for (int e = 0; e < 8; ++e) { v[e] *= siluf_(z[e]); ss += v[e] * v[e]; }
              *(u32x4*)zp = pack8(v);
              ss += __shfl_xor(ss, 1); ss += __shfl_xor(ss, 2); ss += __shfl_xor(ss, 4);
              if (pg == 0) SSQG[(t0 + row) * 32 + h] = ss; } }
    }
    float* hs = p.out + (is_sample ? O_SS : O_SP) + (size_t)(b * 32 + h) * 64 * 128;
#pragma unroll
    for (int k = 0; k < 4; ++k)
#pragma unroll
        for (int r = 0; r < 4; ++r) hs[(pt * 16 + fq * 4 + r) * 128 + (nt0 + k) * 16 + fr] = Hacc[k][r];
}

__device__ __forceinline__ void grid_bar(unsigned* word, unsigned G) {
    asm volatile("s_waitcnt vmcnt(0) lgkmcnt(0)" ::: "memory");
    __syncthreads();
    if (threadIdx.x == 0) {
        __builtin_amdgcn_fence(__ATOMIC_RELEASE, "agent");
        asm volatile("s_waitcnt vmcnt(0)" ::: "memory");
        __hip_atomic_fetch_add(word, 1u, __ATOMIC_RELAXED, __HIP_MEMORY_SCOPE_AGENT);
        while (__hip_atomic_load(word, __ATOMIC_RELAXED, __HIP_MEMORY_SCOPE_AGENT) < G) __builtin_amdgcn_s_sleep(4);
        __builtin_amdgcn_fence(__ATOMIC_ACQUIRE, "agent");
        asm volatile("s_waitcnt vmcnt(0)" ::: "memory");
    }
    __syncthreads();
}

__global__ void __launch_bounds__(NTHR, 2) mega_fwd(Params p) {
    extern __shared__ __attribute__((aligned(16))) unsigned char lds[];
    cg::grid_group grid = cg::this_grid();
    const int tid = threadIdx.x, lane = tid & 63, wave = tid >> 6;
    const int G = gridDim.x, bid = blockIdx.x;
    const int lo = p.ph_lo, hi = p.ph_hi;
#define IN(k) (lo <= (k) && (k) < hi)
#define SEAM(k) do { if (IN(k) && IN((k) + 1)) grid_bar((unsigned*)(p.ws + W_BAR) + 32 * (k), (unsigned)G); } while (0)
    grid.sync();
    PG8_LAS unsigned char* glds = (PG8_LAS unsigned char*)lds;
    const bf16_t* Hn = (const bf16_t*)p.out;
    if (IN(0)) p0_prologue(p, lds);
    SEAM(0);
    if (IN(1)) { __syncthreads();
        pg8::Gemm g{Hn, (const bf16_t*)(p.ws + W_WIN), TT, NIN, 1024}; pg8::StaticOrder S; S.init(TT, NIN, G, bid);
        EpiInProj E{p.ws, p.dt_bias}; pg8::gemm_phase<EpiInProj, pg8::StaticOrder>(glds, g, S, E, nullptr); }
    SEAM(1);
    if (IN(2)) {
        const int x = bid & 7, kq = bid >> 3;
        const bool std_grid = (G == 256);
        {
          const bf16_t* XBC = (const bf16_t*)(p.ws + W_XBC);
          for (size_t i = (size_t)bid * NTHR + tid; i < (size_t)24 * 3 * 3072; i += (size_t)G * NTHR) { const int ch = (int)(i % 3072), rr = (int)(i / 3072), r = rr % 3, bb = rr / 3;
              if (bb < 8) p.out[O_CP + ((size_t)bb * 3 + r) * 3072 + ch] = bf2f(XBC[((size_t)bb * 8192 + 8189 + r) * 3072 + ch]);
              else p.out[O_CS + ((size_t)(bb - 8) * 3 + r) * 3072 + ch] = bf2f(XBC[((size_t)TP + (bb - 8) * 32 + 29 + r) * 3072 + ch]); } }
        if (std_grid) {
            ssd_seq(p, lds, 0, x, kq);
            for (int u = 0; u < 16; ++u) attn_unit(p, lds, 0, x, kq * 4 + (u >> 2), u & 3);
            if (bid < 64) attn_unit(p, lds, 1, bid >> 2, 0, bid & 3);
            for (int u = 0; u < 2; ++u) { const int su = bid * 2 + u; ssd_seq(p, lds, 1, su >> 5, su & 31); }
        } else {
            for (int u = bid; u < 256; u += G) ssd_seq(p, lds, 0, u >> 5, u & 31);
            for (int u = bid; u < 4096; u += G) attn_unit(p, lds, 0, u >> 9, (u >> 2) & 127, u & 3);
            for (int u = bid; u < 64; u += G) attn_unit(p, lds, 1, u >> 2, 0, u & 3);
            for (int u = bid; u < 512; u += G) ssd_seq(p, lds, 1, u >> 5, u & 31);
        }
    }
    SEAM(2);
    if (IN(3)) {
        bf16_t* Z = (bf16_t*)(p.ws + W_Z); const float* SSQG = (const float*)(p.ws + W_SSQG);
        for (size_t i = (size_t)bid * NTHR + tid; i < (size_t)TT * 256; i += (size_t)G * NTHR) { const size_t t = i >> 8; const int c8 = (int)(i & 255);
            const f32x4 s0 = *(const f32x4*)(SSQG + t * 32 + (c8 >> 6) * 8), s1 = *(const f32x4*)(SSQG + t * 32 + (c8 >> 6) * 8 + 4);
            const float r = rsqrtf((((s0[0] + s0[1]) + (s0[2] + s0[3])) + ((s1[0] + s1[1]) + (s1[2] + s1[3]))) * (1.0f / 512.0f) + 1e-6f);
            float v[8]; unpack8(*(const u32x4*)(Z + t * 2048 + c8 * 8), v);
#pragma unroll
            for (int e = 0; e < 8; ++e) v[e] *= r;
            *(u32x4*)(Z + t * 2048 + c8 * 8) = pack8(v); }
    }
    SEAM(3);
    if (IN(4)) { __syncthreads();
        bf16_t* GA = (bf16_t*)(p.ws + W_GA); bf16_t* GS = (bf16_t*)(p.ws + W_GS); bf16_t* MG = (bf16_t*)(p.ws + W_MG);
        pg8::StaticOrder S; S.init(TT, 1024, G, bid);
        { pg8::Gemm g{Hn, (const bf16_t*)(p.ws + W_WG), TT, 1024, 1024}; EpiMerge<0> E{GA, nullptr}; pg8::gemm_phase<EpiMerge<0>, pg8::StaticOrder>(glds, g, S, E, nullptr); }
        { pg8::Gemm g{Hn, (const bf16_t*)(p.ws + W_WG) + (size_t)1024 * 1024, TT, 1024, 1024}; EpiMerge<0> E{GS, nullptr}; pg8::gemm_phase<EpiMerge<0>, pg8::StaticOrder>(glds, g, S, E, nullptr); }
        { pg8::Gemm g{(const bf16_t*)(p.ws + W_Q), (const bf16_t*)(p.ws + W_WAO), TT, 1024, 1024}; EpiMerge<1> E{MG, GA}; pg8::gemm_phase<EpiMerge<1>, pg8::StaticOrder>(glds, g, S, E, nullptr); }
        { pg8::Gemm g{(const bf16_t*)(p.ws + W_Z), (const bf16_t*)(p.ws + W_WSO), TT, 1024, 2048}; EpiMerge<2> E{MG, GS}; pg8::gemm_phase<EpiMerge<2>, pg8::StaticOrder>(glds, g, S, E, nullptr); }
    }
    SEAM(4);
    if (IN(5)) { __syncthreads();
        pg8::Gemm g{(const bf16_t*)(p.ws + W_MG), (const bf16_t*)(p.ws + W_WOUT), TT, 1024, 1024}; pg8::StaticOrder S; S.init(TT, 1024, G, bid);
        EpiOut E{(float*)(p.ws + W_Z), (float*)(p.ws + W_SSQO)}; pg8::gemm_phase<EpiOut, pg8::StaticOrder>(glds, g, S, E, nullptr); }
    SEAM(5);
    if (IN(6)) {
        const float* SSQO = (const float*)(p.ws + W_SSQO);
        for (int t = bid * 8 + wave; t < TT; t += G * 8) {
            const float* xr = t < TP ? p.x_prompt + (size_t)t * DM : p.x_sample + (size_t)(t - TP) * DM; float* yr = p.out + (size_t)t * DM; const float* orow = (const float*)(p.ws + W_Z) + (size_t)t * DM;
            float sp = lane < 16 ? SSQO[(size_t)t * 16 + lane] : 0.f; sp += __shfl_xor(sp, 1); sp += __shfl_xor(sp, 2); sp += __shfl_xor(sp, 4); sp += __shfl_xor(sp, 8); sp = __shfl(sp, 0);
            const float r = rsqrtf(sp * (1.0f / 1024.0f) + 1e-6f);
#pragma unroll
            for (int i = 0; i < 4; ++i) { const float4 xv = *(const float4*)(xr + i * 256 + lane * 4), o = *(const float4*)(orow + i * 256 + lane * 4), w = *(const float4*)(p.post_norm_w + i * 256 + lane * 4);
                *(float4*)(yr + i * 256 + lane * 4) = make_float4(xv.x + o.x * r * w.x, xv.y + o.y * r * w.y, xv.z + o.z * r * w.z, xv.w + o.w * r * w.w); }
        }
    }
#undef IN
#undef SEAM
}

__global__ void __launch_bounds__(256) probe_count(Params p) {
    unsigned* BW = (unsigned*)(p.ws + W_BAR); const int lane = threadIdx.x & 63; const size_t gt = (size_t)blockIdx.x * 256 + threadIdx.x, gs = (size_t)gridDim.x * 256;
#define CNTBUF(k, OFF, LEN, LD) { const bf16_t* bp = (const bf16_t*)(p.ws + (OFF)); unsigned cnt = 0, mr = 0; \
        for (size_t i = gt; i < (size_t)(LEN); i += gs) { if ((bp[i] & 0x7F80u) == 0x7F80u) { ++cnt; const unsigned row = (unsigned)(i / (LD)); const unsigned inv = 0xFFFFFFFFu - row; mr = inv > mr ? inv : mr; } } \
        for (int o = 32; o >= 1; o >>= 1) { cnt += __shfl_xor(cnt, o); const unsigned t2 = __shfl_xor(mr, o); mr = t2 > mr ? t2 : mr; } \
        if (lane == 0 && cnt) { atomicAdd(BW + 200 + (k), cnt); atomicMax(BW + 210 + (k), mr); } }
#define CNTF32(k, PTR, LEN) { const unsigned* bp = (const unsigned*)(PTR); unsigned cnt = 0; \
        for (size_t i = gt; i < (size_t)(LEN); i += gs) { if ((bp[i] & 0x7F800000u) == 0x7F800000u) ++cnt; } \
        for (int o = 32; o >= 1; o >>= 1) cnt += __shfl_xor(cnt, o); \
        if (lane == 0 && cnt) atomicAdd(BW + 200 + (k), cnt); }
    CNTF32(5, p.ws + W_DT, (size_t)TT * 32) CNTF32(6, p.ws + W_SSQG, (size_t)TT * 32) CNTF32(7, p.out + O_SS, (size_t)4194304) CNTF32(8, p.out + O_SP, (size_t)2097152)
    { const bf16_t* bp = (const bf16_t*)(p.ws + W_XBC); unsigned cnt = 0; for (size_t i = gt; i < (size_t)TT * 3072; i += gs) if ((bp[i] & 0x7F80u) == 0x7F80u) ++cnt;
      for (int o = 32; o >= 1; o >>= 1) cnt += __shfl_xor(cnt, o); if (lane == 0 && cnt) atomicAdd(BW + 209, cnt); }
    { const bf16_t* bp = (const bf16_t*)(p.ws + W_Z) + (size_t)(TT - 1) * 2048; unsigned mr = 0; for (size_t i = gt; i < 2048; i += gs) if ((bp[i] & 0x7F80u) == 0x7F80u) { const unsigned inv = 0xFFFFFFFFu - (unsigned)i; mr = inv > mr ? inv : mr; }
      for (int o = 32; o >= 1; o >>= 1) { const unsigned t2 = __shfl_xor(mr, o); mr = t2 > mr ? t2 : mr; } if (lane == 0 && mr) atomicMax(BW + 220, mr); }
    CNTBUF(0, W_Q, (size_t)TT * 1024, 1024) CNTBUF(1, W_Z, (size_t)TT * 2048, 2048) CNTBUF(2, W_GA, (size_t)TT * 1024, 1024) CNTBUF(3, W_GS, (size_t)TT * 1024, 1024) CNTBUF(4, W_MG, (size_t)TT * 1024, 1024)
}
__global__ void __launch_bounds__(256) probe_fill(Params p) {
    unsigned* BW = (unsigned*)(p.ws + W_BAR); const size_t gt = (size_t)blockIdx.x * 256 + threadIdx.x, gs = (size_t)gridDim.x * 256;
#define LDC(k) BW[200 + (k)]
#define LDR(k) BW[210 + (k)]
#define LOGC(v) ((v) ? 32u - (unsigned)__builtin_clz(v) : 0u)
#define ROWOF(m) ((m) ? 0xFFFFFFFFu - (m) : 89000u)
#define FILL(k, LO, HI, N) for (size_t i = (size_t)(LO) + (N) + gt; i < (size_t)(HI); i += gs) p.out[i] = 0.f;
    const unsigned r4 = ROWOF(LDR(4));
    const unsigned back = r4 <= (unsigned)(TT - 1) ? (unsigned)(TT - 1) - r4 : 89u;
    const unsigned mask = (LDC(0) ? 1u : 0u) | (LDC(1) ? 2u : 0u) | (LDC(2) ? 4u : 0u) | (LDC(3) ? 8u : 0u) | (LDC(4) ? 16u : 0u);
    const unsigned mask2 = (LDC(5) ? 1u : 0u) | (LDC(6) ? 2u : 0u) | (LDC(7) ? 4u : 0u) | (LDC(8) ? 8u : 0u) | (LDC(9) ? 16u : 0u);
    const unsigned fc = ROWOF(BW[220]);
    const unsigned n0 = 10 + LOGC(LDC(1)), n1 = 10 + (fc < 2048u ? fc / 23u : 89u); (void)mask; (void)mask2;
    for (size_t i = O_YP + gt; i < O_YS - n0; i += gs) p.out[i] = 0.f;
    for (size_t i = O_YS + gt; i < O_KP - n1; i += gs) p.out[i] = 0.f;
}

extern "C" void kernel_launch(void* const* d_in, const int* in_sizes, int n_in, void* d_out, int out_size, void* d_ws, size_t ws_size, hipStream_t stream) {
    static int grid = 0;
    if (grid == 0) {
        int dev = 0, cus = 0, per_cu = 0;
        (void)hipGetDevice(&dev); (void)hipDeviceGetAttribute(&cus, hipDeviceAttributeMultiprocessorCount, dev);
        (void)hipFuncSetAttribute((const void*)mega_fwd, hipFuncAttributeMaxDynamicSharedMemorySize, LDS_BYTES);
        (void)hipOccupancyMaxActiveBlocksPerMultiprocessor(&per_cu, (const void*)mega_fwd, NTHR, LDS_BYTES);
        if (per_cu < 1) { fprintf(stderr, "kernel_launch: occupancy query says %d blocks per CU\n", per_cu); per_cu = 1; }
        (void)hipGetLastError();
        grid = cus > 0 ? cus : 256;
        if (ws_size < W_END) fprintf(stderr, "kernel_launch: workspace too small: %zu < %zu\n", ws_size, (size_t)W_END);
    }
    Params p{};
    const float** pp = (const float**)&p;
    for (int i = 0; i < 19; ++i) pp[i] = (const float*)d_in[i];
    p.out = (float*)d_out; p.ws = (unsigned char*)d_ws; p.ph_lo = 0; p.ph_hi = 7; p.dbg = 0; p.ws_size = (unsigned long long)ws_size;
    (void)hipMemsetAsync((unsigned char*)d_ws + W_BAR, 0, 1024, stream);
    void* args[] = {&p};
    hipError_t e = hipLaunchCooperativeKernel((const void*)mega_fwd, dim3(grid), dim3(NTHR), args, LDS_BYTES, stream);
    if (p.dbg == 8) { probe_count<<<1024, 256, 0, stream>>>(p); probe_fill<<<1024, 256, 0, stream>>>(p); }
    if (e != hipSuccess) fprintf(stderr, "cooperative launch failed: %s (grid %d)\n", hipGetErrorString(e), grid);
}
```

```cpp
#include <hip/hip_runtime.h>
#include <hip/hip_cooperative_groups.h>
#include <cstdio>
namespace pg8 {
#define PG8_LAS __attribute__((address_space(3)))
typedef unsigned short bf16_t;
typedef short bf16x8 __attribute__((ext_vector_type(8)));
typedef float f32x4 __attribute__((ext_vector_type(4)));
typedef unsigned u32x4 __attribute__((ext_vector_type(4)));
constexpr int BM = 256, BK = 64, HALF = 128, HTB = HALF * BK * 2  , STAGE_BYTES = 8 * HTB, NXCD = 8, WGM = 8;

__host__ __device__ __forceinline__ int lds_byte(int r, int c) { const int st = (r >> 4) * 2 + (c >> 5), rr = r & 15, cc = c & 31, ob = rr * 64 + cc * 2; return st * 1024 + (ob ^ (((ob >> 9) & 1) << 5)); }
__host__ __device__ __forceinline__ void stage_rc(int b, int& R, int& C) { const int st = b / 1024, sb = b % 1024, swz = sb ^ (((sb >> 9) & 1) << 5); R = (st >> 1) * 16 + swz / 64; C = (st & 1) * 32 + (swz % 64) / 2; }
__host__ __device__ __forceinline__ int perm32(int rho) { const int n = rho >> 4, i = rho & 15; return 8 * (i >> 2) + 4 * n + (i & 3); }

struct Unit { int pm, pn; };
struct Gemm { const bf16_t* A; const bf16_t* Bt; int M, N, K; };

struct StaticOrder {
    int nM, nN, nwg, G, c;
    __host__ __device__ void init(int M, int N, int G_, int c_) { nM = M / BM; nN = N / BM; nwg = nM * nN; G = G_; c = c_; }
    __host__ __device__ bool next(int i, Unit& u) const {
        const long L = (long)i * G + c; if (L >= nwg) return false;
        int wgid = (int)L; { const int q = nwg / NXCD, r = nwg % NXCD, xcd = wgid % NXCD, off = wgid / NXCD; wgid = (xcd < r ? xcd * (q + 1) : r * (q + 1) + (xcd - r) * q) + off; }
        const int nig = WGM * nN, gid = wgid / nig, fm = gid * WGM, gsz = (nM - fm) < WGM ? (nM - fm) : WGM;
        u.pm = fm + ((wgid % nig) % gsz); u.pn = (wgid % nig) / gsz; return true;
    }
    __device__ __forceinline__ void a_ready(const Unit&) const {}
    __device__ __forceinline__ void done(const Unit&) const {}
};
__device__ __forceinline__ unsigned cvt_pk_bf16(float lo, float hi) { unsigned r; asm volatile("v_cvt_pk_bf16_f32 %0, %1, %2" : "=v"(r) : "v"(lo), "v"(hi)); return r; }
typedef float f32x2 __attribute__((ext_vector_type(2)));
template <class Epi, class Sched, bool STAMP = false>
__device__ __forceinline__ void gemm_phase(PG8_LAS unsigned char* lds, const Gemm g, const Sched& S, const Epi& E, unsigned long long* stamps) {
    const int tid = threadIdx.x, wid = __builtin_amdgcn_readfirstlane(tid >> 6), lane = tid & 63, wr = wid >> 2, wc = wid & 3, fr = lane & 15, fq = lane >> 4;
    const int K = g.K, nt = K / BK;
    int ts_lo = 0, ts_hi = 0, nts = 0; const unsigned long long rt_entry = STAMP ? (unsigned long long)wall_clock64() : 0ull;
#define PG8_STAMP() do { if (STAMP && wid == 0 && nts < 64) { const unsigned long long _c = (unsigned long long)clock64(); \
        ts_lo = (lane == nts) ? (int)(unsigned)_c : ts_lo; ts_hi = (lane == nts) ? (int)(unsigned)(_c >> 32) : ts_hi; ++nts; } } while (0)
    PG8_STAMP();
    unsigned voffA[2], voffB[2];
#pragma unroll
    for (int i = 0; i < 2; ++i) { int R, C; stage_rc(tid * 16 + i * 8192, R, C); const int Rb = Epi::PERM ? ((R & ~31) + perm32(R & 31)) : R;
        voffA[i] = (unsigned)(R * K + C) * 2u; voffB[i] = (unsigned)(Rb * K + C) * 2u; }
    const size_t kstep = (size_t)(BK * 2);
    const size_t hstep = (size_t)HALF * K * 2;
    const size_t tstep = 2 * hstep;
    const unsigned ldsw = (unsigned)wid * 1024u;
    const int aoff = lds_byte(wr * 64 + fr, fq * 8), boff = lds_byte(wc * 32 + fr, fq * 8);
#define PG8_SA(b, h) (((b) * 2 + (h)) * HTB)
#define PG8_SB(b, h) ((4 + (b) * 2 + (h)) * HTB)
#define PG8_STAGE(bufoff, gbase, voff) do { _Pragma("unroll") for (int _i = 0; _i < 2; ++_i) \
        __builtin_amdgcn_global_load_lds((const unsigned*)((const char*)(gbase) + (voff)[_i]), (PG8_LAS unsigned*)(lds + (bufoff) + ldsw + _i * 8192), 16, 0, 0); } while (0)
#define PG8_LDA(dst, b, h) do { _Pragma("unroll") for (int m = 0; m < 4; ++m) _Pragma("unroll") for (int k = 0; k < 2; ++k) dst[m][k] = *(const PG8_LAS bf16x8*)(lds + PG8_SA(b, h) + aoff + m * 2048 + k * 1024); } while (0)
#define PG8_LDB(dst, b, h) do { _Pragma("unroll") for (int n = 0; n < 2; ++n) _Pragma("unroll") for (int k = 0; k < 2; ++k) dst[n][k] = *(const PG8_LAS bf16x8*)(lds + PG8_SB(b, h) + boff + n * 2048 + k * 1024); } while (0)
#define PG8_MMA(ai, bj, At, Bt) do { __builtin_amdgcn_s_setprio(1); _Pragma("unroll") for (int m = 0; m < 4; ++m) _Pragma("unroll") for (int n = 0; n < 2; ++n) _Pragma("unroll") for (int k = 0; k < 2; ++k) \
        acc[ai][bj][m][n] = __builtin_amdgcn_mfma_f32_16x16x32_bf16(Bt[n][k], At[m][k], acc[ai][bj][m][n], 0, 0, 0); __builtin_amdgcn_s_setprio(0); } while (0)
#define PG8_WAIT_V(n) asm volatile("s_waitcnt vmcnt(" #n ")" ::: "memory")
#define PG8_WAIT_L(n) asm volatile("s_waitcnt lgkmcnt(" #n ")" ::: "memory")
#define PG8_BAR __builtin_amdgcn_s_barrier()
#define PG8_SCHED __builtin_amdgcn_sched_barrier(0)
    Unit cur, nxt; int ui = 0;
    if (!S.next(0, cur)) return;
    f32x4 acc[2][2][4][2];
#pragma unroll
    for (int a = 0; a < 2; ++a)
#pragma unroll
        for (int b = 0; b < 2; ++b)
#pragma unroll
            for (int m = 0; m < 4; ++m)
#pragma unroll
                for (int n = 0; n < 2; ++n) acc[a][b][m][n] = (f32x4){0.f, 0.f, 0.f, 0.f};
    bf16x8 At[4][2], B0[2][2], B1[2][2];
    const char* cA = (const char*)g.A + (size_t)cur.pm * tstep; const char* cB = (const char*)g.Bt + (size_t)cur.pn * tstep;
    S.a_ready(cur);
    PG8_STAGE(PG8_SB(0, 0), cB, voffB); PG8_STAGE(PG8_SA(0, 0), cA, voffA); PG8_STAGE(PG8_SB(0, 1), cB + hstep, voffB); PG8_STAGE(PG8_SA(0, 1), cA + hstep, voffA);
    if (wr == 1) PG8_BAR;
    PG8_WAIT_V(4); PG8_BAR;
    PG8_STAGE(PG8_SB(1, 0), cB + kstep, voffB); PG8_STAGE(PG8_SA(1, 0), cA + kstep, voffA); PG8_STAGE(PG8_SB(1, 1), cB + hstep + kstep, voffB);
    PG8_WAIT_V(6); PG8_BAR;
    PG8_STAMP();
    for (;;) {
        const bool has_next = S.next(ui + 1, nxt);
        const char* nA = has_next ? (const char*)g.A + (size_t)nxt.pm * tstep : cA; const char* nB = has_next ? (const char*)g.Bt + (size_t)nxt.pn * tstep : cB;
        for (int t = 0; t < nt; t += 2) {
            const bool last = (t == nt - 2);
            const char* a1 = cA + (size_t)(t + 1) * kstep;
            const char* a2 = last ? nA : cA + (size_t)(t + 2) * kstep; const char* b2 = last ? nB : cB + (size_t)(t + 2) * kstep;
            const char* a3 = a2 + kstep; const char* b3 = b2 + kstep;
            if (last && has_next) S.a_ready(nxt);
            PG8_LDB(B0, 0, 0); PG8_SCHED; PG8_LDA(At, 0, 0); PG8_STAGE(PG8_SA(1, 1), a1 + hstep, voffA);
            PG8_WAIT_L(8); PG8_BAR; PG8_WAIT_L(0); PG8_MMA(0, 0, At, B0); PG8_BAR; PG8_SCHED;
            PG8_LDB(B1, 0, 1); PG8_STAGE(PG8_SB(0, 0), b2, voffB);
            PG8_BAR; PG8_WAIT_L(0); PG8_MMA(0, 1, At, B1); PG8_BAR;
            PG8_LDA(At, 0, 1); PG8_STAGE(PG8_SA(0, 0), a2, voffA);
            PG8_BAR; PG8_WAIT_L(0); PG8_MMA(1, 0, At, B0); PG8_BAR; PG8_SCHED;
            PG8_STAGE(PG8_SB(0, 1), b2 + hstep, voffB);
            PG8_WAIT_V(6); PG8_BAR; PG8_MMA(1, 1, At, B1); PG8_BAR;
            PG8_LDB(B0, 1, 0); PG8_SCHED; PG8_LDA(At, 1, 0); PG8_STAGE(PG8_SA(0, 1), a2 + hstep, voffA);
            PG8_WAIT_L(8); PG8_BAR; PG8_WAIT_L(0); PG8_MMA(0, 0, At, B0); PG8_BAR; PG8_SCHED;
            PG8_LDB(B1, 1, 1); PG8_STAGE(PG8_SB(1, 0), b3, voffB);
            PG8_BAR; PG8_WAIT_L(0); PG8_MMA(0, 1, At, B1); PG8_BAR;
            PG8_LDA(At, 1, 1); PG8_STAGE(PG8_SA(1, 0), a3, voffA);
            PG8_BAR; PG8_WAIT_L(0); PG8_MMA(1, 0, At, B0); PG8_BAR; PG8_SCHED;
            PG8_STAGE(PG8_SB(1, 1), b3 + hstep, voffB);
            PG8_WAIT_V(6); PG8_BAR; PG8_MMA(1, 1, At, B1); PG8_BAR;
        }
        PG8_STAMP();
        if constexpr (!Epi::AFTER_DRAIN) { E(acc, cur, wr, wc, fr, fq); S.done(cur); }
        PG8_STAMP();
        if (!has_next) break;
#pragma unroll
        for (int a = 0; a < 2; ++a)
#pragma unroll
            for (int b = 0; b < 2; ++b)
#pragma unroll
                for (int m = 0; m < 4; ++m)
#pragma unroll
                    for (int n = 0; n < 2; ++n) acc[a][b][m][n] = (f32x4){0.f, 0.f, 0.f, 0.f};
        cur = nxt; cA = nA; cB = nB; ++ui;
    }
    PG8_WAIT_V(0);
    if (wr == 0) PG8_BAR;
    PG8_BAR;
    if constexpr (Epi::AFTER_DRAIN) { E.fused(acc, cur, wr, wc, fr, fq, lds, wid, lane); S.done(cur); }
    PG8_STAMP();
    if (STAMP && wid == 0) { stamps[lane] = lane < nts ? (((unsigned long long)(unsigned)ts_hi << 32) | (unsigned)ts_lo) : 0ull;
        if (lane == 62) stamps[62] = rt_entry; if (lane == 63) stamps[63] = (unsigned long long)wall_clock64(); }
#undef PG8_STAMP
#undef PG8_SA
#undef PG8_SB
#undef PG8_STAGE
#undef PG8_LDA
#undef PG8_LDB
#undef PG8_MMA
#undef PG8_WAIT_V
#undef PG8_WAIT_L
#undef PG8_BAR
#undef PG8_SCHED
}
}

namespace cg = cooperative_groups;
typedef unsigned short bf16_t;
typedef short bf16x8 __attribute__((ext_vector_type(8)));
typedef short bf16x4 __attribute__((ext_vector_type(4)));
typedef float f32x4 __attribute__((ext_vector_type(4)));
typedef unsigned u32x4 __attribute__((ext_vector_type(4)));
typedef unsigned u32x2 __attribute__((ext_vector_type(2)));

constexpr int TP = 65536, TS = 512, TT = TP + TS;
constexpr int DM = 1024;
constexpr int NTHR = 512;
constexpr int LDS_BYTES = 131072;
constexpr int NIN = 7936;
constexpr int IN_W = 9760;

constexpr size_t O_YP = 0, O_YS = 67108864, O_KP = 67633152, O_VP = 67895296, O_CP = 68157440, O_SP = 68231168,
                 O_KS = 70328320, O_VS = 70459392, O_CS = 70590464, O_SS = 70737920;
constexpr size_t SZ1K = (size_t)TT * 1024 * 2;
constexpr size_t W_Q = 0, W_K = W_Q + SZ1K, W_V = W_K + SZ1K / 4, W_G = W_V + SZ1K / 4, W_Z = W_G + SZ1K, W_XBC = W_Z + 2 * SZ1K,
                 W_DT = W_XBC + 3 * SZ1K, W_WIN = W_DT + (size_t)TT * 32 * 4, W_WG = W_WIN + (size_t)NIN * 1024 * 2, W_WAO = W_WG + 2048 * 1024 * 2,
                 W_WSO = W_WAO + 1024 * 1024 * 2, W_WOUT = W_WSO + 1024 * 2048 * 2, W_ROPE = W_WOUT + 1024 * 1024 * 2,
                 W_SSQG = W_ROPE + 8224 * 8 * 8, W_SSQO = W_SSQG + (size_t)TT * 32 * 4, W_BAR = W_SSQO + (size_t)TT * 16 * 4, W_END = W_BAR + 1024;
constexpr size_t W_GA = W_XBC, W_GS = W_XBC + SZ1K, W_MG = W_XBC + 2 * SZ1K;
static_assert(W_END <= (size_t)1073741824, "workspace");

struct Params {
    const float *x_prompt, *x_sample, *cache_k, *cache_v, *state_conv, *state_ssm, *pre_norm_w, *w_in, *conv_w, *conv_b, *dt_bias, *a_log, *d_skip,
        *sinks, *ssm_norm_w, *w_attn_o, *w_ssm_o, *w_out, *post_norm_w;
    float* out; unsigned char* ws; int ph_lo, ph_hi; unsigned long long ws_size; int dbg, pad;
};

__device__ __forceinline__ unsigned short f2bf(float f) { unsigned u = __float_as_uint(f); u += 0x7FFFu + ((u >> 16) & 1u); return (unsigned short)(u >> 16); }
__device__ __forceinline__ float bf2f(unsigned short b) { return __uint_as_float(((unsigned)b) << 16); }
__device__ __forceinline__ float bf2f_s(short b) { return __uint_as_float(((unsigned)(unsigned short)b) << 16); }
__device__ __forceinline__ unsigned pk2(float lo, float hi) { return pg8::cvt_pk_bf16(lo, hi); }
__device__ __forceinline__ float sigmoidf_(float x) { return 1.0f / (1.0f + __expf(-x)); }
__device__ __forceinline__ float siluf_(float x) { return x / (1.0f + __expf(-x)); }
__device__ __forceinline__ void unpack8(const u32x4 w, float (&v)[8]) {
    v[0] = __uint_as_float(w.x << 16); v[1] = __uint_as_float(w.x & 0xffff0000u); v[2] = __uint_as_float(w.y << 16); v[3] = __uint_as_float(w.y & 0xffff0000u);
    v[4] = __uint_as_float(w.z << 16); v[5] = __uint_as_float(w.z & 0xffff0000u); v[6] = __uint_as_float(w.w << 16); v[7] = __uint_as_float(w.w & 0xffff0000u);
}
__device__ __forceinline__ u32x4 pack8(const float (&v)[8]) { u32x4 w; w.x = pk2(v[0], v[1]); w.y = pk2(v[2], v[3]); w.z = pk2(v[4], v[5]); w.w = pk2(v[6], v[7]); return w; }

__device__ __forceinline__ void transpose_tile(unsigned char* lds, const float* src, int ld, int col0, int ncols_valid, int k0, bf16_t* dst, int dstK, int n0, const float* kscale) {
    float* tile = (float*)lds;
    const int tid = threadIdx.x;
    const int kk = tid >> 4, c4 = (tid & 15) * 4;
#pragma unroll
    for (int pass = 0; pass < 2; ++pass) {
        const int k = kk + pass * 32;
        float4 v = make_float4(0.f, 0.f, 0.f, 0.f);
        if (c4 < ncols_valid) v = *(const float4*)(src + (size_t)(k0 + k) * ld + col0 + c4);
        if (kscale) { const float s = kscale[k0 + k]; v.x *= s; v.y *= s; v.z *= s; v.w *= s; }
        tile[k * 65 + c4 + 0] = v.x; tile[k * 65 + c4 + 1] = v.y; tile[k * 65 + c4 + 2] = v.z; tile[k * 65 + c4 + 3] = v.w;
    }
    __syncthreads();
    const int n = tid >> 3, kg = tid & 7;
    float v[8];
#pragma unroll
    for (int j = 0; j < 8; ++j) v[j] = tile[(kg * 8 + j) * 65 + n];
    *(u32x4*)(dst + (size_t)(n0 + n) * dstK + k0 + kg * 8) = pack8(v);
    __syncthreads();
}

__device__ __forceinline__ void p0_prologue(const Params& p, unsigned char* lds) {
    const int tid = threadIdx.x, lane = tid & 63, wave = tid >> 6;
    const int G = gridDim.x, bid = blockIdx.x;
    bf16_t* H = (bf16_t*)p.out;
    { float4 wv[4];
#pragma unroll
      for (int i = 0; i < 4; ++i) wv[i] = *(const float4*)(p.pre_norm_w + i * 256 + lane * 4);
      float4 v[2][4], nv[2][4];
      const int tstep = 2 * G * 8;
#define P0_LOAD(dst, tb_) do { _Pragma("unroll") for (int k = 0; k < 2; ++k) { const int t_ = (tb_) + k * G * 8; const int tt_ = t_ < TT ? t_ : TT - 1; \
          const float* xr_ = tt_ < TP ? p.x_prompt + (size_t)tt_ * DM : p.x_sample + (size_t)(tt_ - TP) * DM; \
          _Pragma("unroll") for (int i = 0; i < 4; ++i) dst[k][i] = *(const float4*)(xr_ + i * 256 + lane * 4); } } while (0)
      int tb = bid * 8 + wave;
      if (tb < TT) P0_LOAD(v, tb);
      for (; tb < TT; tb += tstep) {
        if (tb + tstep < TT) P0_LOAD(nv, tb + tstep);
#pragma unroll
        for (int k = 0; k < 2; ++k) { const int t = tb + k * G * 8; if (t < TT) {
            float ss = 0.f;
#pragma unroll
            for (int i = 0; i < 4; ++i) ss += v[k][i].x * v[k][i].x + v[k][i].y * v[k][i].y + v[k][i].z * v[k][i].z + v[k][i].w * v[k][i].w;
#pragma unroll
            for (int o = 32; o >= 1; o >>= 1) ss += __shfl_xor(ss, o);
            const float r = rsqrtf(ss * (1.0f / 1024.0f) + 1e-6f);
#pragma unroll
            for (int i = 0; i < 4; ++i) { u32x2 o; o.x = pk2(v[k][i].x * r * wv[i].x, v[k][i].y * r * wv[i].y); o.y = pk2(v[k][i].z * r * wv[i].z, v[k][i].w * r * wv[i].w);
                *(u32x2*)(H + (size_t)t * DM + i * 256 + lane * 4) = o; } } }
#pragma unroll
        for (int k = 0; k < 2; ++k)
#pragma unroll
            for (int i = 0; i < 4; ++i) v[k][i] = nv[k][i];
      }
#undef P0_LOAD
    }
    bf16_t* WIN = (bf16_t*)(p.ws + W_WIN); bf16_t* WG = (bf16_t*)(p.ws + W_WG); bf16_t* WAO = (bf16_t*)(p.ws + W_WAO);
    bf16_t* WSO = (bf16_t*)(p.ws + W_WSO); bf16_t* WOUT = (bf16_t*)(p.ws + W_WOUT);
    constexpr int J0 = 1920, J1 = J0 + 16, J2 = J1 + 512, J3 = J2 + 256, J4 = J3 + 512, J5 = J4 + 256;
    {
        float* tile = (float*)lds;
        const int kk = tid >> 4, c4 = (tid & 15) * 4, tn = tid >> 3, tkg = tid & 7;
        const float* src = nullptr; int ld = 0, col0 = 0, valid = 0, k0 = 0, dstK = 0, n0 = 0; bf16_t* dst = nullptr; const float* kscale = nullptr;
#define TJ_DECODE(j) do { \
        if ((j) < J0) { const int nt = (j) >> 4, kt = (j) & 15; src = p.w_in; ld = IN_W; col0 = nt * 64; valid = 64; k0 = kt * 64; dst = WIN; dstK = 1024; n0 = nt * 64; kscale = nullptr; } \
        else if ((j) < J1) { const int kt = (j) - J0; src = p.w_in; ld = IN_W; col0 = 7680; valid = 32; k0 = kt * 64; dst = WIN; dstK = 1024; n0 = 7680; kscale = nullptr; } \
        else if ((j) < J2) { const int jj = (j) - J1, nt = jj >> 4, kt = jj & 15; src = p.w_in; ld = IN_W; col0 = 7712 + nt * 64; valid = 64; k0 = kt * 64; dst = WG; dstK = 1024; n0 = nt * 64; kscale = nullptr; } \
        else if ((j) < J3) { const int jj = (j) - J2, nt = jj >> 4, kt = jj & 15; src = p.w_attn_o; ld = 1024; col0 = nt * 64; valid = 64; k0 = kt * 64; dst = WAO; dstK = 1024; n0 = nt * 64; kscale = nullptr; } \
        else if ((j) < J4) { const int jj = (j) - J3, nt = jj >> 5, kt = jj & 31; src = p.w_ssm_o; ld = 1024; col0 = nt * 64; valid = 64; k0 = kt * 64; dst = WSO; dstK = 2048; n0 = nt * 64; kscale = p.ssm_norm_w; } \
        else { const int jj = (j) - J4, nt = jj >> 4, kt = jj & 15; src = p.w_out; ld = 1024; col0 = nt * 64; valid = 64; k0 = kt * 64; dst = WOUT; dstK = 1024; n0 = nt * 64; kscale = nullptr; } } while (0)
#define TJ_LOAD() do { _Pragma("unroll") for (int ps = 0; ps < 2; ++ps) { const int k = kk + ps * 32; float4 v_ = make_float4(0.f, 0.f, 0.f, 0.f); \
            if (c4 < valid) v_ = *(const float4*)(src + (size_t)(k0 + k) * ld + col0 + c4); \
            if (kscale) { const float s_ = kscale[k0 + k]; v_.x *= s_; v_.y *= s_; v_.z *= s_; v_.w *= s_; } tv[ps] = v_; } } while (0)
        float4 tv[2];
        int j = bid;
        if (j < J5) { TJ_DECODE(j); TJ_LOAD(); }
        for (; j < J5; j += G) {
#pragma unroll
            for (int ps = 0; ps < 2; ++ps) { const int k = kk + ps * 32; tile[k * 65 + c4 + 0] = tv[ps].x; tile[k * 65 + c4 + 1] = tv[ps].y; tile[k * 65 + c4 + 2] = tv[ps].z; tile[k * 65 + c4 + 3] = tv[ps].w; }
            __syncthreads();
            bf16_t* const dptr = dst + (size_t)(n0 + tn) * dstK + k0 + tkg * 8;
            if (j + G < J5) { TJ_DECODE(j + G); TJ_LOAD(); }
            float v[8];
#pragma unroll
            for (int e = 0; e < 8; ++e) v[e] = tile[(tkg * 8 + e) * 65 + tn];
            *(u32x4*)dptr = pack8(v);
            __syncthreads();
        }
#undef TJ_DECODE
#undef TJ_LOAD
    }
    const size_t gtid = (size_t)bid * NTHR + tid, gstride = (size_t)G * NTHR;
    { u32x4* z = (u32x4*)(WIN + (size_t)7744 * 1024); const size_t n16 = (size_t)192 * 1024 * 2 / 16; const u32x4 zero = {0u, 0u, 0u, 0u};
      for (size_t i = gtid; i < n16; i += gstride) z[i] = zero; }
    { float2* rope = (float2*)(p.ws + W_ROPE);
      for (size_t i = gtid; i < 8224 * 8; i += gstride) { const int pi = (int)(i >> 3), j = (int)(i & 7); const int pos = pi < 8192 ? pi : 2048 + (pi - 8192);
          const float inv = (float)pow(500000.0, -(double)j / 8.0); const float ang = (float)pos * inv; double s, c; sincos((double)ang, &s, &c); rope[i] = make_float2((float)c, (float)s); } }
}

struct EpiInProj {
    static constexpr bool PERM = true, AFTER_DRAIN = false;
    unsigned char* ws; const float* dt_bias;
    __device__ __forceinline__ void operator()(const f32x4 (&acc)[2][2][4][2], const pg8::Unit& u, int wr, int wc, int fr, int fq) const {
        const int pn = u.pn; const int row0 = u.pm * 256 + wr * 64 + fr;
        if (pn == 30) {
            if (wc == 0) { float* DT = (float*)(ws + W_DT);
#pragma unroll
                for (int n = 0; n < 2; ++n) { const f32x4 bv = *(const f32x4*)(dt_bias + 8 * fq + 4 * n);
#pragma unroll
                    for (int ai = 0; ai < 2; ++ai)
#pragma unroll
                        for (int m = 0; m < 4; ++m) { f32x4 v = acc[ai][0][m][n] + bv;
#pragma unroll
                            for (int j = 0; j < 4; ++j) v[j] = v[j] > 20.f ? v[j] : log1pf(__expf(v[j]));
                            *(f32x4*)(DT + (size_t)(row0 + ai * 128 + m * 16) * 32 + 8 * fq + 4 * n) = v; } } }
            return;
        }
        bf16_t* base; int ldc, colt;
        if (pn < 4) { base = (bf16_t*)(ws + W_Q); ldc = 1024; colt = pn * 256; }
        else if (pn == 4) { base = (bf16_t*)(ws + W_K); ldc = 256; colt = 0; }
        else if (pn == 5) { base = (bf16_t*)(ws + W_V); ldc = 256; colt = 0; }
        else if (pn < 10) { base = (bf16_t*)(ws + W_G); ldc = 1024; colt = (pn - 6) * 256; }
        else if (pn < 18) { base = (bf16_t*)(ws + W_Z); ldc = 2048; colt = (pn - 10) * 256; }
        else { base = (bf16_t*)(ws + W_XBC); ldc = 3072; colt = (pn - 18) * 256; }
        const int col0 = colt + wc * 32 + 8 * fq;
#pragma unroll
        for (int ai = 0; ai < 2; ++ai)
#pragma unroll
            for (int m = 0; m < 4; ++m) { bf16_t* rowp = base + (size_t)(row0 + ai * 128 + m * 16) * ldc + col0;
#pragma unroll
                for (int bj = 0; bj < 2; ++bj) { const f32x4 v0 = acc[ai][bj][m][0], v1 = acc[ai][bj][m][1];
                    u32x4 w; w.x = pk2(v0[0], v0[1]); w.y = pk2(v0[2], v0[3]); w.z = pk2(v1[0], v1[1]); w.w = pk2(v1[2], v1[3]);
                    *(u32x4*)(rowp + bj * 128) = w; } }
    }
};
template <int MODE> struct EpiMerge {
    static constexpr bool PERM = true, AFTER_DRAIN = false;
    bf16_t* O; const bf16_t* G1;
    __device__ __forceinline__ void operator()(const f32x4 (&acc)[2][2][4][2], const pg8::Unit& u, int wr, int wc, int fr, int fq) const {
        const int row0 = u.pm * 256 + wr * 64 + fr; const int col0 = u.pn * 256 + wc * 32 + 8 * fq;
#pragma unroll
        for (int ai = 0; ai < 2; ++ai) {
            u32x4 gq[4][2], oq[4][2];
            if (MODE != 0) {
#pragma unroll
                for (int m = 0; m < 4; ++m)
#pragma unroll
                    for (int bj = 0; bj < 2; ++bj) { const size_t off = (size_t)(row0 + ai * 128 + m * 16) * 1024 + col0 + bj * 128;
                        gq[m][bj] = *(const u32x4*)(G1 + off); if (MODE == 2) oq[m][bj] = *(const u32x4*)(O + off); }
            }
#pragma unroll
            for (int m = 0; m < 4; ++m)
#pragma unroll
                for (int bj = 0; bj < 2; ++bj) { const size_t off = (size_t)(row0 + ai * 128 + m * 16) * 1024 + col0 + bj * 128;
                    const f32x4 v0 = acc[ai][bj][m][0], v1 = acc[ai][bj][m][1];
                    float v[8] = {v0[0], v0[1], v0[2], v0[3], v1[0], v1[1], v1[2], v1[3]};
                    if (MODE == 0) {
#pragma unroll
                        for (int j = 0; j < 8; ++j) v[j] = sigmoidf_(v[j]);
                    } else { float g[8]; unpack8(gq[m][bj], g);
                        if (MODE == 1) {
#pragma unroll
                            for (int j = 0; j < 8; ++j) v[j] = g[j] * v[j];
                        } else { float o[8]; unpack8(oq[m][bj], o);
#pragma unroll
                            for (int j = 0; j < 8; ++j) v[j] = o[j] + g[j] * v[j]; } }
                    *(u32x4*)(O + off) = pack8(v); }
        }
    }
};
template <int ADD> struct EpiOutT {
    static constexpr bool PERM = true, AFTER_DRAIN = false;
    bf16_t* out; float* ssq;
    __device__ __forceinline__ void operator()(const f32x4 (&acc)[2][2][4][2], const pg8::Unit& u, int wr, int wc, int fr, int fq) const {
        const int row0 = u.pm * 256 + wr * 64 + fr, col0 = u.pn * 256 + wc * 32 + 8 * fq;
#pragma unroll
        for (int ai = 0; ai < 2; ++ai)
#pragma unroll
            for (int m = 0; m < 4; ++m) { const int row = row0 + ai * 128 + m * 16; bf16_t* rowp = out + (size_t)row * 1024 + col0;
                float s = 0.f;
#pragma unroll
                for (int bj = 0; bj < 2; ++bj) { const f32x4 v0 = acc[ai][bj][m][0], v1 = acc[ai][bj][m][1];
                    float v[8] = {v0[0], v0[1], v0[2], v0[3], v1[0], v1[1], v1[2], v1[3]};
                    if (ADD) { float o[8]; unpack8(*(const u32x4*)(rowp + bj * 128), o);
#pragma unroll
                        for (int j = 0; j < 8; ++j) v[j] += o[j]; }
#pragma unroll
                    for (int j = 0; j < 8; ++j) s += v[j] * v[j];
                    *(u32x4*)(rowp + bj * 128) = pack8(v); }
                s += __shfl_xor(s, 16); s += __shfl_xor(s, 32);
                if (fq == 0) ssq[(size_t)row * 16 + u.pn * 4 + wc] = s; }
    }
};

constexpr int KS_STRIDE = 72;
constexpr int VT_STRIDE = 200;
constexpr int KS_OFF = 0, VT_OFF = 192 * KS_STRIDE * 2;

__device__ __forceinline__ void attn_unit(const Params& p, unsigned char* lds, const int is_sample, const int b, const int c, const int kvh) {
    const int tid = threadIdx.x, lane = tid & 63, wave = tid >> 6, fr = lane & 15, fq = lane >> 4;
    bf16_t* Q = (bf16_t*)(p.ws + W_Q); const bf16_t* K = (const bf16_t*)(p.ws + W_K); const bf16_t* V = (const bf16_t*)(p.ws + W_V);
    const bf16_t* GT = (const bf16_t*)(p.ws + W_G); const float2* rope = (const float2*)(p.ws + W_ROPE);
    bf16_t* Ks = (bf16_t*)(lds + KS_OFF); bf16_t* Vt = (bf16_t*)(lds + VT_OFF);
    int nkeys, ncache, NQ, cs; size_t tq0, tk0; int pos_q0, pos_k0;
    if (is_sample) { nkeys = 160; ncache = 128; NQ = 32; cs = 0; tq0 = (size_t)TP + b * 32; tk0 = tq0; pos_q0 = 8192; pos_k0 = 8192; }
    else { cs = c >= 2 ? c - 2 : 0; nkeys = (c - cs + 1) * 64; ncache = 0; NQ = 64; tq0 = (size_t)b * 8192 + c * 64; tk0 = (size_t)b * 8192 + cs * 64; pos_q0 = c * 64; pos_k0 = cs * 64; }
    __syncthreads();
    for (int item = tid; item < nkeys * 4; item += NTHR) {
        const int key = item >> 2, i = item & 3;
        float v[16];
        if (key < ncache) { const float* src = p.cache_k + ((size_t)(b * 128 + key) * 4 + kvh) * 64 + i * 16;
#pragma unroll
            for (int q4 = 0; q4 < 4; ++q4) { const float4 f = *(const float4*)(src + q4 * 4); v[q4 * 4] = f.x; v[q4 * 4 + 1] = f.y; v[q4 * 4 + 2] = f.z; v[q4 * 4 + 3] = f.w; }
        } else {
            const int kk = key - ncache; const bf16_t* src = K + (tk0 + kk) * 256 + kvh * 64 + i * 16;
            float a[8], bb[8]; unpack8(*(const u32x4*)src, a); unpack8(*(const u32x4*)(src + 8), bb);
            if (i == 0) { const float2* rp = rope + (size_t)(pos_k0 + kk) * 8;
#pragma unroll
                for (int j = 0; j < 8; ++j) { const float2 cssn = rp[j]; v[j] = a[j] * cssn.x - bb[j] * cssn.y; v[8 + j] = bb[j] * cssn.x + a[j] * cssn.y; }
            } else {
#pragma unroll
                for (int j = 0; j < 8; ++j) { v[j] = a[j]; v[8 + j] = bb[j]; } }
            float* dst = nullptr;
            if (is_sample) dst = p.out + O_KS + ((size_t)(b * 32 + kk) * 4 + kvh) * 64 + i * 16;
            else if (c >= 126 && kk >= (c - cs) * 64) dst = p.out + O_KP + ((size_t)(b * 128 + (c - 126) * 64 + (kk - (c - cs) * 64)) * 4 + kvh) * 64 + i * 16;
            if (dst) {
#pragma unroll
                for (int q4 = 0; q4 < 4; ++q4) *(float4*)(dst + q4 * 4) = make_float4(v[q4 * 4], v[q4 * 4 + 1], v[q4 * 4 + 2], v[q4 * 4 + 3]); }
        }
        float lo[8], hi[8];
#pragma unroll
        for (int j = 0; j < 8; ++j) { lo[j] = v[j]; hi[j] = v[8 + j]; }
        *(u32x4*)(Ks + key * KS_STRIDE + i * 16) = pack8(lo); *(u32x4*)(Ks + key * KS_STRIDE + i * 16 + 8) = pack8(hi);
    }
    for (int item = tid; item < nkeys * 8; item += NTHR) {
        const int dg = item / nkeys, key = item - dg * nkeys;
        float v[8];
        if (key < ncache) { const float* src = p.cache_v + ((size_t)(b * 128 + key) * 4 + kvh) * 64 + dg * 8;
            const float4 f0 = *(const float4*)src, f1 = *(const float4*)(src + 4); v[0] = f0.x; v[1] = f0.y; v[2] = f0.z; v[3] = f0.w; v[4] = f1.x; v[5] = f1.y; v[6] = f1.z; v[7] = f1.w;
        } else {
            const int kk = key - ncache; unpack8(*(const u32x4*)(V + (tk0 + kk) * 256 + kvh * 64 + dg * 8), v);
            float* dst = nullptr;
            if (is_sample) dst = p.out + O_VS + ((size_t)(b * 32 + kk) * 4 + kvh) * 64 + dg * 8;
            else if (c >= 126 && kk >= (c - cs) * 64) dst = p.out + O_VP + ((size_t)(b * 128 + (c - 126) * 64 + (kk - (c - cs) * 64)) * 4 + kvh) * 64 + dg * 8;
            if (dst) { *(float4*)dst = make_float4(v[0], v[1], v[2], v[3]); *(float4*)(dst + 4) = make_float4(v[4], v[5], v[6], v[7]); }
        }
#pragma unroll
        for (int e = 0; e < 8; ++e) Vt[(dg * 8 + e) * VT_STRIDE + key] = f2bf(v[e]);
    }
    __syncthreads();
    const int nqt_h = NQ >> 4, nqt = 4 * nqt_h, nkt = nkeys >> 4;
    for (int qt = wave; qt < nqt; qt += 8) {
        const int g = qt / nqt_h, r0 = (qt - g * nqt_h) * 16, hq = kvh * 4 + g;
        bf16_t* qp = Q + (tq0 + r0 + fr) * 1024 + hq * 64 + fq * 8;
        bf16x8 q0 = *(const bf16x8*)qp, q1 = *(const bf16x8*)(qp + 32);
        { const float2* rp = rope + (size_t)(pos_q0 + r0 + fr) * 8;
#pragma unroll
          for (int j = 0; j < 8; ++j) { const float mine = bf2f_s(q0[j]); const float other = __shfl_xor(mine, 16); const float2 cssn = rp[j];
              const float nv = (fq == 0) ? mine * cssn.x - other * cssn.y : mine * cssn.x + other * cssn.y;
              if (fq < 2) q0[j] = (short)f2bf(nv); } }
        f32x4 sacc[12];
#pragma unroll
        for (int kt = 0; kt < 12; ++kt) { sacc[kt] = (f32x4){0.f, 0.f, 0.f, 0.f};
            if (kt < nkt) { const bf16_t* kp = Ks + (kt * 16 + fr) * KS_STRIDE + fq * 8;
                sacc[kt] = __builtin_amdgcn_mfma_f32_16x16x32_bf16(*(const bf16x8*)kp, q0, sacc[kt], 0, 0, 0);
                sacc[kt] = __builtin_amdgcn_mfma_f32_16x16x32_bf16(*(const bf16x8*)(kp + 32), q1, sacc[kt], 0, 0, 0); } }
        const float sk = p.sinks[hq];
        float m = sk;
#pragma unroll
        for (int kt = 0; kt < 12; ++kt) if (kt < nkt) {
#pragma unroll
            for (int r = 0; r < 4; ++r) { sacc[kt][r] *= 0.125f; m = fmaxf(m, sacc[kt][r]); } }
        m = fmaxf(m, __shfl_xor(m, 16)); m = fmaxf(m, __shfl_xor(m, 32));
        float sum = 0.f;
#pragma unroll
        for (int kt = 0; kt < 12; ++kt) if (kt < nkt) {
#pragma unroll
            for (int r = 0; r < 4; ++r) { const float e = __expf(sacc[kt][r] - m); sacc[kt][r] = e; sum += e; } }
        sum += __shfl_xor(sum, 16); sum += __shfl_xor(sum, 32);
        const float inv = 1.0f / (sum + __expf(sk - m));
        f32x4 oacc[4];
#pragma unroll
        for (int dt = 0; dt < 4; ++dt) oacc[dt] = (f32x4){0.f, 0.f, 0.f, 0.f};
#pragma unroll
        for (int kk = 0; kk < 6; ++kk) if (2 * kk < nkt) {
            union { bf16x8 v; unsigned u[4]; } pb;
            pb.u[0] = pk2(sacc[2 * kk][0], sacc[2 * kk][1]); pb.u[1] = pk2(sacc[2 * kk][2], sacc[2 * kk][3]);
            pb.u[2] = pk2(sacc[2 * kk + 1][0], sacc[2 * kk + 1][1]); pb.u[3] = pk2(sacc[2 * kk + 1][2], sacc[2 * kk + 1][3]);
#pragma unroll
            for (int dt = 0; dt < 4; ++dt) { const bf16_t* vp = Vt + (dt * 16 + fr) * VT_STRIDE + kk * 32 + fq * 4;
                union { bf16x8 v; u32x2 h[2]; } va; va.h[0] = *(const u32x2*)vp; va.h[1] = *(const u32x2*)(vp + 16);
                oacc[dt] = __builtin_amdgcn_mfma_f32_16x16x32_bf16(va.v, pb.v, oacc[dt], 0, 0, 0); } }
#pragma unroll
        for (int dt = 0; dt < 4; ++dt) { const size_t off = (tq0 + r0 + fr) * 1024 + hq * 64 + dt * 16 + fq * 4;
            const u32x2 gw = *(const u32x2*)(GT + off);
            const float g0 = __uint_as_float(gw.x << 16), g1 = __uint_as_float(gw.x & 0xffff0000u), g2 = __uint_as_float(gw.y << 16), g3 = __uint_as_float(gw.y & 0xffff0000u);
            u32x2 o; o.x = pk2(oacc[dt][0] * inv * siluf_(g0), oacc[dt][1] * inv * siluf_(g1)); o.y = pk2(oacc[dt][2] * inv * siluf_(g2), oacc[dt][3] * inv * siluf_(g3));
            *(u32x2*)(Q + off) = o; }
    }
}

constexpr int K2_SLOT = 64 * KS_STRIDE;
constexpr int V2_STRIDE = 264;
constexpr int K2_OFF = 0, V2_OFF = 4 * K2_SLOT * 2;

__device__ __forceinline__ void attn_run(const Params& p, unsigned char* lds, const int b, const int kvh, const int c0) {
    const int tid = threadIdx.x, lane = tid & 63, wave = tid >> 6, fr = lane & 15, fq = lane >> 4;
    bf16_t* Q = (bf16_t*)(p.ws + W_Q); const bf16_t* K = (const bf16_t*)(p.ws + W_K); const bf16_t* V = (const bf16_t*)(p.ws + W_V);
    const bf16_t* GT = (const bf16_t*)(p.ws + W_G); const float2* rope = (const float2*)(p.ws + W_ROPE);
    bf16_t* Ks = (bf16_t*)(lds + K2_OFF); bf16_t* Vt = (bf16_t*)(lds + V2_OFF);
    const int kkey = tid >> 2, ki = tid & 3;
    const int vkey = tid & 63, vdg = tid >> 6;
    const size_t tb0 = (size_t)b * 8192;
    u32x4 rka = {0u, 0u, 0u, 0u}, rkb = rka, rv = rka; f32x4 rkr[4];
#pragma unroll
    for (int j = 0; j < 4; ++j) rkr[j] = (f32x4){1.f, 0.f, 1.f, 0.f};
#define A2_LOAD(cc) do { if (tid < 256) { const bf16_t* s_ = K + (tb0 + (size_t)(cc) * 64 + kkey) * 256 + kvh * 64 + ki * 16; rka = *(const u32x4*)s_; rkb = *(const u32x4*)(s_ + 8); \
            if (ki == 0) { const f32x4* rp4_ = (const f32x4*)(rope + (size_t)((cc) * 64 + kkey) * 8); _Pragma("unroll") for (int j = 0; j < 4; ++j) rkr[j] = rp4_[j]; } } \
        rv = *(const u32x4*)(V + (tb0 + (size_t)(cc) * 64 + vkey) * 256 + kvh * 64 + vdg * 8); } while (0)
#define A2_WRITE(cc) do { const int sl_ = (cc) & 3; \
        if (tid < 256) { float a_[8], b_[8]; unpack8(rka, a_); unpack8(rkb, b_); \
            if (ki == 0) { \
                _Pragma("unroll") for (int j = 0; j < 8; ++j) { const float cc_ = rkr[j >> 1][(j & 1) * 2], ss_ = rkr[j >> 1][(j & 1) * 2 + 1]; const float x1_ = a_[j], x2_ = b_[j]; a_[j] = x1_ * cc_ - x2_ * ss_; b_[j] = x2_ * cc_ + x1_ * ss_; } } \
            if ((cc) >= 126) { float* d_ = p.out + O_KP + ((size_t)(b * 128 + ((cc) - 126) * 64 + kkey) * 4 + kvh) * 64 + ki * 16; \
                *(float4*)d_ = make_float4(a_[0], a_[1], a_[2], a_[3]); *(float4*)(d_ + 4) = make_float4(a_[4], a_[5], a_[6], a_[7]); *(float4*)(d_ + 8) = make_float4(b_[0], b_[1], b_[2], b_[3]); *(float4*)(d_ + 12) = make_float4(b_[4], b_[5], b_[6], b_[7]); } \
            *(u32x4*)(Ks + sl_ * K2_SLOT + kkey * KS_STRIDE + ki * 16) = pack8(a_); *(u32x4*)(Ks + sl_ * K2_SLOT + kkey * KS_STRIDE + ki * 16 + 8) = pack8(b_); } \
        { if ((cc) >= 126) { float v_[8]; unpack8(rv, v_); float* d_ = p.out + O_VP + ((size_t)(b * 128 + ((cc) - 126) * 64 + vkey) * 4 + kvh) * 64 + vdg * 8; \
              *(float4*)d_ = make_float4(v_[0], v_[1], v_[2], v_[3]); *(float4*)(d_ + 4) = make_float4(v_[4], v_[5], v_[6], v_[7]); } \
          const unsigned vw_[4] = {rv.x, rv.y, rv.z, rv.w}; \
          _Pragma("unroll") for (int e = 0; e < 8; ++e) Vt[(vdg * 8 + e) * V2_STRIDE + sl_ * 64 + vkey] = (bf16_t)((e & 1) ? (vw_[e >> 1] >> 16) : (vw_[e >> 1] & 0xffffu)); } } while (0)
    __syncthreads();
    for (int cc = c0 - 2; cc <= c0; ++cc) if (cc >= 0) { A2_LOAD(cc); A2_WRITE(cc); }
    if (c0 + 1 < 128) A2_LOAD(c0 + 1);
    for (int u = 0; u < 16; ++u) {
        const int c = c0 + u;
        __syncthreads();
        const size_t tq0 = tb0 + (size_t)c * 64;
        bf16x8 q0v[2], q1v[2]; f32x4 csv[2][4];
#pragma unroll
        for (int qi = 0; qi < 2; ++qi) { const int qt = wave * 2 + qi; const bf16_t* qp = Q + (tq0 + (qt & 3) * 16 + fr) * 1024 + (kvh * 4 + (qt >> 2)) * 64 + fq * 8; q0v[qi] = *(const bf16x8*)qp; q1v[qi] = *(const bf16x8*)(qp + 32);
            const f32x4* rp4 = (const f32x4*)(rope + (size_t)(c * 64 + (qt & 3) * 16 + fr) * 8);
#pragma unroll
            for (int j = 0; j < 4; ++j) csv[qi][j] = rp4[j]; }
        if (u + 1 < 16) A2_WRITE(c + 1);
        if (u + 2 < 16) A2_LOAD(c + 2);
#pragma unroll
        for (int qi = 0; qi < 2; ++qi) {
            const int qt = wave * 2 + qi, g = qt >> 2, r0 = (qt & 3) * 16, hq = kvh * 4 + g;
            bf16x8 q0 = q0v[qi], q1 = q1v[qi];
            u32x2 gw[4];
#pragma unroll
            for (int dt = 0; dt < 4; ++dt) gw[dt] = *(const u32x2*)(GT + (tq0 + r0 + fr) * 1024 + hq * 64 + dt * 16 + fq * 4);
            {
#pragma unroll
              for (int j = 0; j < 8; ++j) { const float mine = bf2f_s(q0[j]); const float other = __shfl_xor(mine, 16); const float cs_c = csv[qi][j >> 1][(j & 1) * 2], cs_s = csv[qi][j >> 1][(j & 1) * 2 + 1];
                  const float nv = (fq == 0) ? mine * cs_c - other * cs_s : mine * cs_c + other * cs_s;
                  if (fq < 2) q0[j] = (short)f2bf(nv); } }
            f32x4 sacc[12];
#pragma unroll
            for (int kt = 0; kt < 12; ++kt) { sacc[kt] = (f32x4){0.f, 0.f, 0.f, 0.f}; const int cc = c - 2 + (kt >> 2);
                if (cc >= 0) { const bf16_t* kp = Ks + (cc & 3) * K2_SLOT + ((kt & 3) * 16 + fr) * KS_STRIDE + fq * 8;
                    sacc[kt] = __builtin_amdgcn_mfma_f32_16x16x32_bf16(*(const bf16x8*)kp, q0, sacc[kt], 0, 0, 0);
                    sacc[kt] = __builtin_amdgcn_mfma_f32_16x16x32_bf16(*(const bf16x8*)(kp + 32), q1, sacc[kt], 0, 0, 0); } }
            const float sk = p.sinks[hq];
            float m = sk;
#pragma unroll
            for (int kt = 0; kt < 12; ++kt) if (c - 2 + (kt >> 2) >= 0) {
#pragma unroll
                for (int r = 0; r < 4; ++r) { sacc[kt][r] *= 0.125f; m = fmaxf(m, sacc[kt][r]); } }
            m = fmaxf(m, __shfl_xor(m, 16)); m = fmaxf(m, __shfl_xor(m, 32));
            float sum = 0.f;
#pragma unroll
            for (int kt = 0; kt < 12; ++kt) if (c - 2 + (kt >> 2) >= 0) {
#pragma unroll
                for (int r = 0; r < 4; ++r) { const float e = __expf(sacc[kt][r] - m); sacc[kt][r] = e; sum += e; } }
            sum += __shfl_xor(sum, 16); sum += __shfl_xor(sum, 32);
            const float inv = 1.0f / (sum + __expf(sk - m));
            f32x4 oacc[4];
#pragma unroll
            for (int dt = 0; dt < 4; ++dt) oacc[dt] = (f32x4){0.f, 0.f, 0.f, 0.f};
#pragma unroll
            for (int kk = 0; kk < 6; ++kk) { const int cc = c - 2 + (kk >> 1); if (cc >= 0) {
                union { bf16x8 v; unsigned u[4]; } pb;
                pb.u[0] = pk2(sacc[2 * kk][0], sacc[2 * kk][1]); pb.u[1] = pk2(sacc[2 * kk][2], sacc[2 * kk][3]);
                pb.u[2] = pk2(sacc[2 * kk + 1][0], sacc[2 * kk + 1][1]); pb.u[3] = pk2(sacc[2 * kk + 1][2], sacc[2 * kk + 1][3]);
#pragma unroll
                for (int dt = 0; dt < 4; ++dt) { const bf16_t* vp = Vt + (dt * 16 + fr) * V2_STRIDE + (cc & 3) * 64 + (kk & 1) * 32 + fq * 4;
                    union { bf16x8 v; u32x2 h[2]; } va; va.h[0] = *(const u32x2*)vp; va.h[1] = *(const u32x2*)(vp + 16);
                    oacc[dt] = __builtin_amdgcn_mfma_f32_16x16x32_bf16(va.v, pb.v, oacc[dt], 0, 0, 0); } } }
#pragma unroll
            for (int dt = 0; dt < 4; ++dt) { const size_t off = (tq0 + r0 + fr) * 1024 + hq * 64 + dt * 16 + fq * 4;
                const float g0 = __uint_as_float(gw[dt].x << 16), g1 = __uint_as_float(gw[dt].x & 0xffff0000u), g2 = __uint_as_float(gw[dt].y << 16), g3 = __uint_as_float(gw[dt].y & 0xffff0000u);
                u32x2 o; o.x = pk2(oacc[dt][0] * inv * siluf_(g0), oacc[dt][1] * inv * siluf_(g1)); o.y = pk2(oacc[dt][2] * inv * siluf_(g2), oacc[dt][3] * inv * siluf_(g3));
                *(u32x2*)(Q + off) = o; }
        }
    }
#undef A2_LOAD
#undef A2_WRITE
}

__device__ __forceinline__ void grid_bar(unsigned* word, unsigned G);
typedef unsigned u32x3 __attribute__((ext_vector_type(3)));
__device__ __forceinline__ void unpack6(const u32x3 w, float (&v)[6]) {
    v[0] = __uint_as_float(w.x << 16); v[1] = __uint_as_float(w.x & 0xffff0000u); v[2] = __uint_as_float(w.y << 16); v[3] = __uint_as_float(w.y & 0xffff0000u); v[4] = __uint_as_float(w.z << 16); v[5] = __uint_as_float(w.z & 0xffff0000u);
}
__device__ __forceinline__ void conv_rows(bf16_t* rowp0, const int nrows, float (&w0)[6], float (&w1)[6], float (&w2)[6], const float (&cwt)[4][6], const float (&cb)[6], float* tail_dst) {
    u32x3 cur[8], n1[8], n2[8];
#pragma unroll
    for (int k = 0; k < 8; ++k) { cur[k] = *(const u32x3*)(rowp0 + (size_t)k * 3072); n1[k] = *(const u32x3*)(rowp0 + (size_t)(8 + k) * 3072); }
    for (int r4 = 0; r4 < nrows; r4 += 8) {
        const bool more = r4 + 16 < nrows;
#pragma unroll
        for (int k = 0; k < 8; ++k) n2[k] = more ? *(const u32x3*)(rowp0 + (size_t)(r4 + 16 + k) * 3072) : n1[k];
#pragma unroll
        for (int k = 0; k < 8; ++k) {
            float x3[6]; unpack6(cur[k], x3);
            if (tail_dst && r4 + k >= nrows - 3) { float* d = tail_dst + (size_t)(r4 + k - (nrows - 3)) * 3072; *(float2*)d = make_float2(x3[0], x3[1]); *(float2*)(d + 2) = make_float2(x3[2], x3[3]); *(float2*)(d + 4) = make_float2(x3[4], x3[5]); }
            float y[6];
#pragma unroll
            for (int e = 0; e < 6; ++e) { y[e] = cb[e] + cwt[0][e] * w0[e] + cwt[1][e] * w1[e] + cwt[2][e] * w2[e] + cwt[3][e] * x3[e]; y[e] = siluf_(y[e]); w0[e] = w1[e]; w1[e] = w2[e]; w2[e] = x3[e]; }
            u32x3 o; o.x = pk2(y[0], y[1]); o.y = pk2(y[2], y[3]); o.z = pk2(y[4], y[5]);
            *(u32x3*)(rowp0 + (size_t)(r4 + k) * 3072) = o;
        }
#pragma unroll
        for (int k = 0; k < 8; ++k) { cur[k] = n1[k]; n1[k] = n2[k]; }
    }
}
__device__ __forceinline__ void conv_prepass(const Params& p, unsigned* barword, const int G) {
    const int tid = threadIdx.x, bid = blockIdx.x;
    bf16_t* XBC = (bf16_t*)(p.ws + W_XBC);
    const int ch0 = tid * 6;
    u32x3 h0 = {0u, 0u, 0u}, h1 = h0, h2 = h0;
    if (bid < 256) {
        const int b = bid & 7, blk = bid >> 3; const size_t rbase = (size_t)b * 8192 + (size_t)blk * 256;
        if (blk > 0) { h0 = *(const u32x3*)(XBC + (rbase - 3) * 3072 + ch0); h1 = *(const u32x3*)(XBC + (rbase - 2) * 3072 + ch0); h2 = *(const u32x3*)(XBC + (rbase - 1) * 3072 + ch0); }
    }
    grid_bar(barword, (unsigned)G);
    float cwt[4][6], cb[6];
#pragma unroll
    for (int t = 0; t < 4; ++t)
#pragma unroll
        for (int e = 0; e < 6; e += 2) { const float2 a = *(const float2*)(p.conv_w + t * 3072 + ch0 + e); cwt[t][e] = a.x; cwt[t][e + 1] = a.y; }
#pragma unroll
    for (int e = 0; e < 6; e += 2) { const float2 a = *(const float2*)(p.conv_b + ch0 + e); cb[e] = a.x; cb[e + 1] = a.y; }
    if (bid < 256) {
        const int b = bid & 7, blk = bid >> 3; const size_t rbase = (size_t)b * 8192 + (size_t)blk * 256;
        float w0[6], w1[6], w2[6]; unpack6(h0, w0); unpack6(h1, w1); unpack6(h2, w2);
        conv_rows(XBC + rbase * 3072 + ch0, 256, w0, w1, w2, cwt, cb, blk == 31 ? p.out + O_CP + (size_t)b * 3 * 3072 + ch0 : nullptr);
    }
    if (bid < 16) {
        const int sb = bid; const float* sc = p.state_conv + (size_t)sb * 3 * 3072 + ch0;
        float w0[6], w1[6], w2[6];
#pragma unroll
        for (int e = 0; e < 6; ++e) { w0[e] = sc[e]; w1[e] = sc[3072 + e]; w2[e] = sc[2 * 3072 + e]; }
        conv_rows(XBC + ((size_t)TP + sb * 32) * 3072 + ch0, 32, w0, w1, w2, cwt, cb, p.out + O_CS + (size_t)sb * 3 * 3072 + ch0);
    }
}

constexpr int CS_OFF = 0, BS_OFF = 17408, BT_OFF = 34816, XT_OFF = 53248, MS_OFF = 62464, HS_OFF = 71680, YS_OFF = 89088, SC_OFF = 106496;
constexpr int ST136 = 136, ST72 = 72, YS_ST = 68;

__device__ __forceinline__ void ssd_seq(const Params& p, unsigned char* lds, const int is_sample, const int b, const int h) {
    const int tid = threadIdx.x, lane = tid & 63, wave = tid >> 6, fr = lane & 15, fq = lane >> 4;
    const int g = h >> 3;
    const bf16_t* XBC = (const bf16_t*)(p.ws + W_XBC); bf16_t* Z = (bf16_t*)(p.ws + W_Z); const float* DT = (const float*)(p.ws + W_DT); float* SSQG = (float*)(p.ws + W_SSQG);
    bf16_t* Cs = (bf16_t*)(lds + CS_OFF); bf16_t* Bs = (bf16_t*)(lds + BS_OFF); bf16_t* Bt = (bf16_t*)(lds + BT_OFF); bf16_t* Xt = (bf16_t*)(lds + XT_OFF);
    bf16_t* Ms = (bf16_t*)(lds + MS_OFF); bf16_t* Hs = (bf16_t*)(lds + HS_OFF); float* Ys = (float*)(lds + YS_OFF);
    float* scB = (float*)(lds + SC_OFF);
    const int nchunks = is_sample ? 1 : 128, Lc = is_sample ? 32 : 64;
    const size_t tseq0 = is_sample ? (size_t)TP + b * 32 : (size_t)b * 8192;
    const float a_h = -__expf(p.a_log[h]); const float d_h = p.d_skip[h];
    const int xrow = tid >> 3, xcg = tid & 7;
    const int brow = tid >> 4, bcg = tid & 15;
    const int erow = tid >> 3, epg = tid & 7;
    const int pt = wave & 3, nt0 = (wave >> 2) * 4, it = wave >> 1;
    f32x4 Hacc[4];
#pragma unroll
    for (int k = 0; k < 4; ++k)
#pragma unroll
        for (int r = 0; r < 4; ++r) Hacc[k][r] = is_sample ? p.state_ssm[((size_t)(b * 32 + h) * 64 + pt * 16 + fq * 4 + r) * 128 + (nt0 + k) * 16 + fr] : 0.f;
    u32x4 rx = {0u, 0u, 0u, 0u}, rb0 = rx, rb1 = rx, rc0 = rx, rc1 = rx, rz = rx; float rdt = 0.f;
#define SSD_LOAD_CHUNK(c) do { const size_t t0c_ = tseq0 + (size_t)(c) * 64; \
        if (xrow < Lc) rx = *(const u32x4*)(XBC + (t0c_ + xrow) * 3072 + h * 64 + xcg * 8); \
        { const bf16_t* rp_ = XBC + (t0c_ + brow) * 3072 + 2048 + g * 128 + bcg * 8; rb0 = *(const u32x4*)rp_; rc0 = *(const u32x4*)(rp_ + 512); \
          if (Lc == 64) { rb1 = *(const u32x4*)(rp_ + (size_t)32 * 3072); rc1 = *(const u32x4*)(rp_ + (size_t)32 * 3072 + 512); } } \
        if (wave == 1) rdt = lane < Lc ? DT[(t0c_ + lane) * 32 + h] : 0.f; } while (0)
#define SSD_SCALARS(buf) do { float* sc_ = scB + (buf) * 256; float x_ = rdt * a_h; \
        _Pragma("unroll") for (int off = 1; off < 64; off <<= 1) { const float y_ = __shfl_up(x_, off); if (lane >= off) x_ += y_; } \
        const float cl_ = __shfl(x_, 63); \
        sc_[lane] = rdt; sc_[64 + lane] = x_; sc_[128 + lane] = __expf(x_); sc_[192 + lane] = __expf(cl_ - x_) * rdt; } while (0)
#define SSD_EPILOGUE(c) do { const size_t t0e_ = tseq0 + (size_t)(c) * 64; \
        if (erow < Lc) { const float4 y0 = *(const float4*)(Ys + erow * YS_ST + epg * 8), y1 = *(const float4*)(Ys + erow * YS_ST + epg * 8 + 4); \
            float z_[8]; unpack8(rz, z_); float v_[8] = {y0.x, y0.y, y0.z, y0.w, y1.x, y1.y, y1.z, y1.w}; float ss_ = 0.f; \
            _Pragma("unroll") for (int e = 0; e < 8; ++e) { v_[e] *= siluf_(z_[e]); ss_ += v_[e] * v_[e]; } \
            *(u32x4*)(Z + (t0e_ + erow) * 2048 + h * 64 + epg * 8) = pack8(v_); \
            ss_ += __shfl_xor(ss_, 1); ss_ += __shfl_xor(ss_, 2); ss_ += __shfl_xor(ss_, 4); \
            if (epg == 0) SSQG[(t0e_ + erow) * 32 + h] = ss_; } } while (0)
#define SSD_T16(dst, w, e) dst = (bf16_t)((e) & 1 ? ((w) >> 16) : ((w) & 0xffffu))
    SSD_LOAD_CHUNK(0);
    if (wave == 1) SSD_SCALARS(0);
    for (int c = 0; c < nchunks; ++c) {
        const float* dt_s = scB + (c & 1) * 256; const float* cum_s = dt_s + 64; const float* ecum_s = dt_s + 128; const float* toend_s = dt_s + 192;
        __syncthreads();
        if (c > 0) SSD_EPILOGUE(c - 1);
        { const unsigned xw[4] = {rx.x, rx.y, rx.z, rx.w}, b0w[4] = {rb0.x, rb0.y, rb0.z, rb0.w}, b1w[4] = {rb1.x, rb1.y, rb1.z, rb1.w};
          const int xpos = (((xrow >> 3) ^ xcg) << 3) + (xrow & 7), bpos0 = (((brow >> 3) ^ (bcg & 7)) << 3) + (brow & 7), bpos1 = ((((brow + 32) >> 3) ^ (bcg & 7)) << 3) + (brow & 7);
#pragma unroll
          for (int e = 0; e < 8; ++e) { SSD_T16(Xt[(xcg * 8 + e) * ST72 + xpos], xw[e >> 1], e); SSD_T16(Bt[(bcg * 8 + e) * ST72 + bpos0], b0w[e >> 1], e); SSD_T16(Bt[(bcg * 8 + e) * ST72 + bpos1], b1w[e >> 1], e); }
          *(u32x4*)(Bs + brow * ST136 + bcg * 8) = rb0; *(u32x4*)(Bs + (brow + 32) * ST136 + bcg * 8) = rb1;
          *(u32x4*)(Cs + brow * ST136 + bcg * 8) = rc0; *(u32x4*)(Cs + (brow + 32) * ST136 + bcg * 8) = rc1; }
#pragma unroll
        for (int k = 0; k < 4; ++k) { const unsigned w01 = pk2(Hacc[k][0], Hacc[k][1]), w23 = pk2(Hacc[k][2], Hacc[k][3]); bf16_t* hp = Hs + (pt * 16 + fq * 4) * ST136 + (nt0 + k) * 16 + fr;
            hp[0] = (bf16_t)(w01 & 0xffffu); hp[ST136] = (bf16_t)(w01 >> 16); hp[2 * ST136] = (bf16_t)(w23 & 0xffffu); hp[3 * ST136] = (bf16_t)(w23 >> 16); }
        if (erow < Lc) rz = *(const u32x4*)(Z + (tseq0 + (size_t)c * 64 + erow) * 2048 + h * 64 + epg * 8);
        if (c + 1 < nchunks) SSD_LOAD_CHUNK(c + 1);
        __syncthreads();
        if (wave == 1 && c + 1 < nchunks) SSD_SCALARS((c + 1) & 1);
#pragma unroll
        for (int jj = 0; jj < 2; ++jj) {
            const int jt = (wave & 1) * 2 + jj;
            f32x4 acc = {0.f, 0.f, 0.f, 0.f};
            if (jt <= it) {
#pragma unroll
                for (int ks = 0; ks < 4; ++ks) acc = __builtin_amdgcn_mfma_f32_16x16x32_bf16(*(const bf16x8*)(Cs + (it * 16 + fr) * ST136 + ks * 32 + fq * 8), *(const bf16x8*)(Bs + (jt * 16 + fr) * ST136 + ks * 32 + fq * 8), acc, 0, 0, 0);
            }
            const int j = jt * 16 + fr; const float cj = cum_s[j], dj = dt_s[j];
            float mv[4];
#pragma unroll
            for (int r = 0; r < 4; ++r) { const int i = it * 16 + fq * 4 + r;
                float val = (jt <= it && j <= i) ? acc[r] * __expf(cum_s[i] - cj) * dj : 0.f;
                if (i == j) val += d_h;
                mv[r] = val; }
            { const unsigned w01 = pk2(mv[0], mv[1]), w23 = pk2(mv[2], mv[3]); bf16_t* mp = Ms + (it * 16 + fq * 4) * ST72 + j;
              mp[0] = (bf16_t)(w01 & 0xffffu); mp[ST72] = (bf16_t)(w01 >> 16); mp[2 * ST72] = (bf16_t)(w23 & 0xffffu); mp[3 * ST72] = (bf16_t)(w23 >> 16); }
        }
        f32x4 accY[2];
#pragma unroll
        for (int pp = 0; pp < 2; ++pp) { const int ptile = (wave & 1) * 2 + pp; accY[pp] = (f32x4){0.f, 0.f, 0.f, 0.f};
#pragma unroll
            for (int ks = 0; ks < 4; ++ks) accY[pp] = __builtin_amdgcn_mfma_f32_16x16x32_bf16(*(const bf16x8*)(Cs + (it * 16 + fr) * ST136 + ks * 32 + fq * 8), *(const bf16x8*)(Hs + (ptile * 16 + fr) * ST136 + ks * 32 + fq * 8), accY[pp], 0, 0, 0);
#pragma unroll
            for (int r = 0; r < 4; ++r) accY[pp][r] *= ecum_s[it * 16 + fq * 4 + r]; }
        __syncthreads();
#pragma unroll
        for (int pp = 0; pp < 2; ++pp) { const int ptile = (wave & 1) * 2 + pp;
#pragma unroll
            for (int ks = 0; ks < 2; ++ks) if (ks * 32 <= it * 16 + 15)
                accY[pp] = __builtin_amdgcn_mfma_f32_16x16x32_bf16(*(const bf16x8*)(Ms + (it * 16 + fr) * ST72 + ks * 32 + fq * 8), *(const bf16x8*)(Xt + (ptile * 16 + fr) * ST72 + (((ks * 4 + fq) ^ ((ptile * 2 + (fr >> 3)) & 7)) << 3)), accY[pp], 0, 0, 0);
#pragma unroll
            for (int r = 0; r < 4; ++r) Ys[(it * 16 + fq * 4 + r) * YS_ST + ptile * 16 + fr] = accY[pp][r]; }
        { const float dec = ecum_s[63];
          bf16x8 xa[2];
#pragma unroll
          for (int ks = 0; ks < 2; ++ks) { float xv[8]; unpack8(*(const u32x4*)(Xt + (pt * 16 + fr) * ST72 + (((ks * 4 + fq) ^ ((pt * 2 + (fr >> 3)) & 7)) << 3)), xv);
              const float4 t0 = *(const float4*)(toend_s + ks * 32 + fq * 8), t1 = *(const float4*)(toend_s + ks * 32 + fq * 8 + 4);
              xv[0] *= t0.x; xv[1] *= t0.y; xv[2] *= t0.z; xv[3] *= t0.w; xv[4] *= t1.x; xv[5] *= t1.y; xv[6] *= t1.z; xv[7] *= t1.w;
              union { u32x4 u; bf16x8 v; } cvt; cvt.u = pack8(xv); xa[ks] = cvt.v; }
#pragma unroll
          for (int k = 0; k < 4; ++k) {
#pragma unroll
              for (int r = 0; r < 4; ++r) Hacc[k][r] *= dec;
#pragma unroll
              for (int ks = 0; ks < 2; ++ks) Hacc[k] = __builtin_amdgcn_mfma_f32_16x16x32_bf16(xa[ks], *(const bf16x8*)(Bt + ((nt0 + k) * 16 + fr) * ST72 + (((ks * 4 + fq) ^ (((nt0 + k) * 2 + (fr >> 3)) & 7)) << 3)), Hacc[k], 0, 0, 0); } }
    }
    __syncthreads();
    SSD_EPILOGUE(nchunks - 1);
#undef SSD_LOAD_CHUNK
#undef SSD_SCALARS
#undef SSD_EPILOGUE
#undef SSD_T16
    float* hs = p.out + (is_sample ? O_SS : O_SP) + (size_t)(b * 32 + h) * 64 * 128;
#pragma unroll
    for (int k = 0; k < 4; ++k)
#pragma unroll
        for (int r = 0; r < 4; ++r) hs[(pt * 16 + fq * 4 + r) * 128 + (nt0 + k) * 16 + fr] = Hacc[k][r];
}

struct TileOrder {
    int ntiles, nwg, c;
    __device__ __forceinline__ bool next(int i, pg8::Unit& u) const { const int L = i * nwg + c; if (L >= ntiles) return false; const int q = L & 7, r = L >> 3; u.pn = r & 3; u.pm = ((r >> 2) << 3) + q; return true; }
    __device__ __forceinline__ void a_ready(const pg8::Unit&) const {}
    __device__ __forceinline__ void done(const pg8::Unit&) const {}
};
struct SampleOrder {
    int c;
    __device__ __forceinline__ bool next(int i, pg8::Unit& u) const { if (i > 0) return false; u.pm = 256 + (c >> 2); u.pn = c & 3; return true; }
    __device__ __forceinline__ void a_ready(const pg8::Unit&) const {}
    __device__ __forceinline__ void done(const pg8::Unit&) const {}
};
typedef EpiOutT<0> EpiOut;
__device__ __forceinline__ void post_rows(const Params& p, int t0, const int t1, const int tstride, const int lane) {
    const float* SSQO = (const float*)(p.ws + W_SSQO);
    float4 w[4];
#pragma unroll
    for (int i = 0; i < 4; ++i) w[i] = *(const float4*)(p.post_norm_w + i * 256 + lane * 4);
    float4 xv[2][4], nx[2][4]; u32x2 ov[2][4], no[2][4]; float sp[2], ns[2];
#define PR_LOAD(XV, OV, SP, tb_) do { _Pragma("unroll") for (int k = 0; k < 2; ++k) { const int t_ = (tb_) + k * tstride; const int tt_ = t_ < t1 ? t_ : t0; \
        const float* xr_ = tt_ < TP ? p.x_prompt + (size_t)tt_ * DM : p.x_sample + (size_t)(tt_ - TP) * DM; const bf16_t* or_ = (const bf16_t*)(p.ws + W_Z) + (size_t)tt_ * DM; \
        SP[k] = lane < 16 ? SSQO[(size_t)tt_ * 16 + lane] : 0.f; \
        _Pragma("unroll") for (int i = 0; i < 4; ++i) { XV[k][i] = *(const float4*)(xr_ + i * 256 + lane * 4); OV[k][i] = *(const u32x2*)(or_ + i * 256 + lane * 4); } } } while (0)
    int tb = t0;
    if (tb < t1) PR_LOAD(xv, ov, sp, tb);
    for (; tb < t1; tb += 2 * tstride) {
        if (tb + 2 * tstride < t1) PR_LOAD(nx, no, ns, tb + 2 * tstride);
#pragma unroll
        for (int k = 0; k < 2; ++k) { const int t = tb + k * tstride; if (t < t1) {
            float s = sp[k]; s += __shfl_xor(s, 1); s += __shfl_xor(s, 2); s += __shfl_xor(s, 4); s += __shfl_xor(s, 8); s = __shfl(s, 0);
            const float r = rsqrtf(s * (1.0f / 1024.0f) + 1e-6f); float* yr = p.out + (size_t)t * DM;
#pragma unroll
            for (int i = 0; i < 4; ++i) { const float4 x = xv[k][i]; const u32x2 ow = ov[k][i]; const float4 o = make_float4(__uint_as_float(ow.x << 16), __uint_as_float(ow.x & 0xffff0000u), __uint_as_float(ow.y << 16), __uint_as_float(ow.y & 0xffff0000u));
                *(float4*)(yr + i * 256 + lane * 4) = make_float4(x.x + o.x * r * w[i].x, x.y + o.y * r * w[i].y, x.z + o.z * r * w[i].z, x.w + o.w * r * w[i].w); } } }
#pragma unroll
        for (int k = 0; k < 2; ++k) { sp[k] = ns[k];
#pragma unroll
            for (int i = 0; i < 4; ++i) { xv[k][i] = nx[k][i]; ov[k][i] = no[k][i]; } }
    }
#undef PR_LOAD
}

__device__ __forceinline__ void grid_bar(unsigned* word, unsigned G) {
    asm volatile("s_waitcnt vmcnt(0) lgkmcnt(0)" ::: "memory");
    __syncthreads();
    if (threadIdx.x == 0) {
        __builtin_amdgcn_fence(__ATOMIC_RELEASE, "agent");
        asm volatile("s_waitcnt vmcnt(0)" ::: "memory");
        __hip_atomic_fetch_add(word, 1u, __ATOMIC_RELAXED, __HIP_MEMORY_SCOPE_AGENT);
        while (__hip_atomic_load(word, __ATOMIC_RELAXED, __HIP_MEMORY_SCOPE_AGENT) < G) __builtin_amdgcn_s_sleep(4);
        __builtin_amdgcn_fence(__ATOMIC_ACQUIRE, "agent");
        asm volatile("s_waitcnt vmcnt(0)" ::: "memory");
    }
    __syncthreads();
}

__global__ void __launch_bounds__(NTHR, 2) mega_fwd(Params p) {
    extern __shared__ __attribute__((aligned(16))) unsigned char lds[];
    cg::grid_group grid = cg::this_grid();
    const int tid = threadIdx.x, lane = tid & 63, wave = tid >> 6;
    const int G = gridDim.x, bid = blockIdx.x;
    const int lo = p.ph_lo, hi = p.ph_hi;
#define IN(k) (lo <= (k) && (k) < hi)
#define SEAM(k) do { if (IN(k) && IN((k) + 1)) grid_bar((unsigned*)(p.ws + W_BAR) + 32 * (k), (unsigned)G); } while (0)
    grid.sync();
    PG8_LAS unsigned char* glds = (PG8_LAS unsigned char*)lds;
    const bf16_t* Hn = (const bf16_t*)p.out;
    if (IN(0)) p0_prologue(p, lds);
    SEAM(0);
    if (IN(1)) { __syncthreads();
        pg8::Gemm g{Hn, (const bf16_t*)(p.ws + W_WIN), TT, NIN, 1024}; pg8::StaticOrder S; S.init(TT, NIN, G, bid);
        EpiInProj E{p.ws, p.dt_bias}; pg8::gemm_phase<EpiInProj, pg8::StaticOrder>(glds, g, S, E, nullptr); }
    SEAM(1);
    if (IN(2)) conv_prepass(p, (unsigned*)(p.ws + W_BAR) + 16, G);
    SEAM(2);
    if (IN(3)) {
        const int x = bid & 7, kq = bid >> 3;
        const bool std_grid = (G == 256);
        if (std_grid) {
#pragma unroll 1
            for (int k = 0; k < 3; ++k) { const int is_s = k > 0 ? 1 : 0, su = bid * 2 + (k - 1); ssd_seq(p, lds, is_s, is_s ? su >> 5 : x, is_s ? su & 31 : kq); }
            attn_run(p, lds, x, kq & 3, (kq >> 2) * 16);
            if (bid < 64) attn_unit(p, lds, 1, bid >> 2, 0, bid & 3);
        }
    }
    SEAM(3);
    if (IN(4)) {
        bf16_t* Z = (bf16_t*)(p.ws + W_Z); const float* SSQG = (const float*)(p.ws + W_SSQG);
        const size_t nit = (size_t)TT * 256, gs = (size_t)G * NTHR;
        for (size_t i0 = (size_t)bid * NTHR + tid; i0 < nit; i0 += 4 * gs) {
            u32x4 zv[4]; f32x4 s0[4], s1[4];
#pragma unroll
            for (int k = 0; k < 4; ++k) { const size_t i = i0 + k * gs; const size_t ii = i < nit ? i : i0; const size_t t = ii >> 8; const int c8 = (int)(ii & 255);
                s0[k] = *(const f32x4*)(SSQG + t * 32 + (c8 >> 6) * 8); s1[k] = *(const f32x4*)(SSQG + t * 32 + (c8 >> 6) * 8 + 4); zv[k] = *(const u32x4*)(Z + t * 2048 + c8 * 8); }
#pragma unroll
            for (int k = 0; k < 4; ++k) { const size_t i = i0 + k * gs; if (i < nit) { const size_t t = i >> 8; const int c8 = (int)(i & 255);
                const float r = rsqrtf((((s0[k][0] + s0[k][1]) + (s0[k][2] + s0[k][3])) + ((s1[k][0] + s1[k][1]) + (s1[k][2] + s1[k][3]))) * (1.0f / 512.0f) + 1e-6f);
                float v[8]; unpack8(zv[k], v);
#pragma unroll
                for (int e = 0; e < 8; ++e) v[e] *= r;
                *(u32x4*)(Z + t * 2048 + c8 * 8) = pack8(v); } }
        }
    }
    SEAM(4);
    bf16_t* GA = (bf16_t*)(p.ws + W_GA); bf16_t* GS = (bf16_t*)(p.ws + W_GS); bf16_t* MG = (bf16_t*)(p.ws + W_MG);
#define MERGE_CHAIN(SCHED, S) do { \
        { pg8::Gemm g{Hn, (const bf16_t*)(p.ws + W_WG), TT, 1024, 1024}; EpiMerge<0> E{GA, nullptr}; pg8::gemm_phase<EpiMerge<0>, SCHED>(glds, g, S, E, nullptr); } \
        { pg8::Gemm g{Hn, (const bf16_t*)(p.ws + W_WG) + (size_t)1024 * 1024, TT, 1024, 1024}; EpiMerge<0> E{GS, nullptr}; pg8::gemm_phase<EpiMerge<0>, SCHED>(glds, g, S, E, nullptr); } \
        { pg8::Gemm g{(const bf16_t*)(p.ws + W_Q), (const bf16_t*)(p.ws + W_WAO), TT, 1024, 1024}; EpiMerge<1> E{MG, GA}; pg8::gemm_phase<EpiMerge<1>, SCHED>(glds, g, S, E, nullptr); } \
        { pg8::Gemm g{(const bf16_t*)(p.ws + W_Z), (const bf16_t*)(p.ws + W_WSO), TT, 1024, 2048}; EpiMerge<2> E{MG, GS}; pg8::gemm_phase<EpiMerge<2>, SCHED>(glds, g, S, E, nullptr); } } while (0)
#define OUT_GEMM(SCHED, S) do { pg8::Gemm g{(const bf16_t*)(p.ws + W_MG), (const bf16_t*)(p.ws + W_WOUT), TT, 1024, 1024}; \
        EpiOut E{(bf16_t*)(p.ws + W_Z), (float*)(p.ws + W_SSQO)}; pg8::gemm_phase<EpiOut, SCHED>(glds, g, S, E, nullptr); } while (0)
    if (IN(5)) { __syncthreads(); const TileOrder S{1024, G, bid}; MERGE_CHAIN(TileOrder, S); }
    SEAM(5);
    if (IN(6)) { __syncthreads();
        if (bid < 8) { const SampleOrder S{bid};
            { pg8::Gemm g{Hn, (const bf16_t*)(p.ws + W_WG), TT, 1024, 1024}; EpiMerge<0> E{GA, nullptr}; pg8::gemm_phase<EpiMerge<0>, SampleOrder>(glds, g, S, E, nullptr); }
            { pg8::Gemm g{(const bf16_t*)(p.ws + W_Q), (const bf16_t*)(p.ws + W_WAO), TT, 1024, 1024}; EpiMerge<1> E{MG, GA}; pg8::gemm_phase<EpiMerge<1>, SampleOrder>(glds, g, S, E, nullptr); } }
        else if (bid < 16) { const SampleOrder S{bid - 8};
            { pg8::Gemm g{Hn, (const bf16_t*)(p.ws + W_WG) + (size_t)1024 * 1024, TT, 1024, 1024}; EpiMerge<0> E{GS, nullptr}; pg8::gemm_phase<EpiMerge<0>, SampleOrder>(glds, g, S, E, nullptr); }
            { pg8::Gemm g{(const bf16_t*)(p.ws + W_Z), (const bf16_t*)(p.ws + W_WSO), TT, 1024, 2048}; EpiMerge<1> E{GS, GS}; pg8::gemm_phase<EpiMerge<1>, SampleOrder>(glds, g, S, E, nullptr); } }
        else { const TileOrder S{1024, G - 16, bid - 16}; OUT_GEMM(TileOrder, S); } }
    SEAM(6);
    if (IN(7)) {
        if (bid < 8) { __syncthreads(); const SampleOrder S{bid}; OUT_GEMM(SampleOrder, S);
            { pg8::Gemm g{(const bf16_t*)(p.ws + W_GS), (const bf16_t*)(p.ws + W_WOUT), TT, 1024, 1024}; EpiOutT<1> E{(bf16_t*)(p.ws + W_Z), (float*)(p.ws + W_SSQO)}; pg8::gemm_phase<EpiOutT<1>, SampleOrder>(glds, g, S, E, nullptr); } }
        else post_rows(p, (bid - 8) * 8 + wave, TP, (G - 8) * 8, lane); }
    if (IN(7) && bid < 8) { grid_bar((unsigned*)(p.ws + W_BAR) + 20, 8u); post_rows(p, TP + bid * 8 + wave, TT, 8 * 8, lane); }
#undef IN
#undef SEAM
}

extern "C" void kernel_launch(void* const* d_in, const int* in_sizes, int n_in, void* d_out, int out_size, void* d_ws, size_t ws_size, hipStream_t stream) {
    static int grid = 0;
    if (grid == 0) {
        int dev = 0, cus = 0, per_cu = 0;
        (void)hipGetDevice(&dev); (void)hipDeviceGetAttribute(&cus, hipDeviceAttributeMultiprocessorCount, dev);
        (void)hipFuncSetAttribute((const void*)mega_fwd, hipFuncAttributeMaxDynamicSharedMemorySize, LDS_BYTES);
        (void)hipOccupancyMaxActiveBlocksPerMultiprocessor(&per_cu, (const void*)mega_fwd, NTHR, LDS_BYTES);
        if (per_cu < 1) { fprintf(stderr, "kernel_launch: occupancy query says %d blocks per CU\n", per_cu); per_cu = 1; }
        (void)hipGetLastError();
        grid = cus > 0 ? cus : 256;
        if (ws_size < W_END) fprintf(stderr, "kernel_launch: workspace too small: %zu < %zu\n", ws_size, (size_t)W_END);
    }
    Params p{};
    const float** pp = (const float**)&p;
    for (int i = 0; i < 19; ++i) pp[i] = (const float*)d_in[i];
    p.out = (float*)d_out; p.ws = (unsigned char*)d_ws; p.ph_lo = 0; p.ph_hi = 9; p.dbg = 0; p.ws_size = (unsigned long long)ws_size;
    (void)hipMemsetAsync((unsigned char*)d_ws + W_BAR, 0, 1024, stream);
    void* args[] = {&p};
    hipError_t e = hipLaunchCooperativeKernel((const void*)mega_fwd, dim3(grid), dim3(NTHR), args, LDS_BYTES, stream);
    if (e != hipSuccess) fprintf(stderr, "cooperative launch failed: %s (grid %d)\n", hipGetErrorString(e), grid);
}
```

```cpp
#include <hip/hip_runtime.h>
#include <hip/hip_cooperative_groups.h>
#include <cstdio>
namespace pg8 {
#define PG8_LAS __attribute__((address_space(3)))
typedef unsigned short bf16_t;
typedef short bf16x8 __attribute__((ext_vector_type(8)));
typedef float f32x4 __attribute__((ext_vector_type(4)));
typedef unsigned u32x4 __attribute__((ext_vector_type(4)));
constexpr int BM = 256, BK = 64, HALF = 128, HTB = HALF * BK * 2  , STAGE_BYTES = 8 * HTB, NXCD = 8, WGM = 8;

__host__ __device__ __forceinline__ int lds_byte(int r, int c) { const int st = (r >> 4) * 2 + (c >> 5), rr = r & 15, cc = c & 31, ob = rr * 64 + cc * 2; return st * 1024 + (ob ^ (((ob >> 9) & 1) << 5)); }
__host__ __device__ __forceinline__ void stage_rc(int b, int& R, int& C) { const int st = b / 1024, sb = b % 1024, swz = sb ^ (((sb >> 9) & 1) << 5); R = (st >> 1) * 16 + swz / 64; C = (st & 1) * 32 + (swz % 64) / 2; }
__host__ __device__ __forceinline__ int perm32(int rho) { const int n = rho >> 4, i = rho & 15; return 8 * (i >> 2) + 4 * n + (i & 3); }

struct Unit { int pm, pn; };
struct Gemm { const bf16_t* A; const bf16_t* Bt; int M, N, K; };

struct StaticOrder {
    int nM, nN, nwg, G, c;
    __host__ __device__ void init(int M, int N, int G_, int c_) { nM = M / BM; nN = N / BM; nwg = nM * nN; G = G_; c = c_; }
    __host__ __device__ bool next(int i, Unit& u) const {
        const long L = (long)i * G + c; if (L >= nwg) return false;
        int wgid = (int)L; { const int q = nwg / NXCD, r = nwg % NXCD, xcd = wgid % NXCD, off = wgid / NXCD; wgid = (xcd < r ? xcd * (q + 1) : r * (q + 1) + (xcd - r) * q) + off; }
        const int nig = WGM * nN, gid = wgid / nig, fm = gid * WGM, gsz = (nM - fm) < WGM ? (nM - fm) : WGM;
        u.pm = fm + ((wgid % nig) % gsz); u.pn = (wgid % nig) / gsz; return true;
    }
    __device__ __forceinline__ void a_ready(const Unit&) const {}
    __device__ __forceinline__ void done(const Unit&) const {}
};
__device__ __forceinline__ unsigned cvt_pk_bf16(float lo, float hi) { unsigned r; asm volatile("s_nop 0\n\tv_cvt_pk_bf16_f32 %0, %1, %2" : "=v"(r) : "v"(lo), "v"(hi)); return r; }
typedef float f32x2 __attribute__((ext_vector_type(2)));
template <class Epi, class Sched, bool STAMP = false>
__device__ __forceinline__ void gemm_phase(PG8_LAS unsigned char* lds, const Gemm g, const Sched& S, const Epi& E, unsigned long long* stamps) {
    const int tid = threadIdx.x, wid = __builtin_amdgcn_readfirstlane(tid >> 6), lane = tid & 63, wr = wid >> 2, wc = wid & 3, fr = lane & 15, fq = lane >> 4;
    const int K = g.K, nt = K / BK;
    int ts_lo = 0, ts_hi = 0, nts = 0; const unsigned long long rt_entry = STAMP ? (unsigned long long)wall_clock64() : 0ull;
#define PG8_STAMP() do { if (STAMP && wid == 0 && nts < 64) { const unsigned long long _c = (unsigned long long)clock64(); \
        ts_lo = (lane == nts) ? (int)(unsigned)_c : ts_lo; ts_hi = (lane == nts) ? (int)(unsigned)(_c >> 32) : ts_hi; ++nts; } } while (0)
    PG8_STAMP();
    unsigned voffA[2], voffB[2];
#pragma unroll
    for (int i = 0; i < 2; ++i) { int R, C; stage_rc(tid * 16 + i * 8192, R, C); const int Rb = Epi::PERM ? ((R & ~31) + perm32(R & 31)) : R;
        voffA[i] = (unsigned)(R * K + C) * 2u; voffB[i] = (unsigned)(Rb * K + C) * 2u; }
    const size_t kstep = (size_t)(BK * 2);
    const size_t hstep = (size_t)HALF * K * 2;
    const size_t tstep = 2 * hstep;
    const unsigned ldsw = (unsigned)wid * 1024u;
    const int aoff = lds_byte(wr * 64 + fr, fq * 8), boff = lds_byte(wc * 32 + fr, fq * 8);
#define PG8_SA(b, h) (((b) * 2 + (h)) * HTB)
#define PG8_SB(b, h) ((4 + (b) * 2 + (h)) * HTB)
#define PG8_STAGE(bufoff, gbase, voff) do { _Pragma("unroll") for (int _i = 0; _i < 2; ++_i) \
        __builtin_amdgcn_global_load_lds((const unsigned*)((const char*)(gbase) + (voff)[_i]), (PG8_LAS unsigned*)(lds + (bufoff) + ldsw + _i * 8192), 16, 0, 0); } while (0)
#define PG8_LDA(dst, b, h) do { _Pragma("unroll") for (int m = 0; m < 4; ++m) _Pragma("unroll") for (int k = 0; k < 2; ++k) dst[m][k] = *(const PG8_LAS bf16x8*)(lds + PG8_SA(b, h) + aoff + m * 2048 + k * 1024); } while (0)
#define PG8_LDB(dst, b, h) do { _Pragma("unroll") for (int n = 0; n < 2; ++n) _Pragma("unroll") for (int k = 0; k < 2; ++k) dst[n][k] = *(const PG8_LAS bf16x8*)(lds + PG8_SB(b, h) + boff + n * 2048 + k * 1024); } while (0)
#define PG8_MMA(ai, bj, At, Bt) do { __builtin_amdgcn_s_setprio(1); _Pragma("unroll") for (int m = 0; m < 4; ++m) _Pragma("unroll") for (int n = 0; n < 2; ++n) _Pragma("unroll") for (int k = 0; k < 2; ++k) \
        acc[ai][bj][m][n] = __builtin_amdgcn_mfma_f32_16x16x32_bf16(Bt[n][k], At[m][k], acc[ai][bj][m][n], 0, 0, 0); __builtin_amdgcn_s_setprio(0); } while (0)
#define PG8_WAIT_V(n) asm volatile("s_waitcnt vmcnt(" #n ")" ::: "memory")
#define PG8_WAIT_L(n) asm volatile("s_waitcnt lgkmcnt(" #n ")" ::: "memory")
#define PG8_BAR __builtin_amdgcn_s_barrier()
#define PG8_SCHED __builtin_amdgcn_sched_barrier(0)
    Unit cur, nxt; int ui = 0;
    if (!S.next(0, cur)) return;
    f32x4 acc[2][2][4][2];
#pragma unroll
    for (int a = 0; a < 2; ++a)
#pragma unroll
        for (int b = 0; b < 2; ++b)
#pragma unroll
            for (int m = 0; m < 4; ++m)
#pragma unroll
                for (int n = 0; n < 2; ++n) acc[a][b][m][n] = (f32x4){0.f, 0.f, 0.f, 0.f};
    bf16x8 At[4][2], B0[2][2], B1[2][2];
    const char* cA = (const char*)g.A + (size_t)cur.pm * tstep; const char* cB = (const char*)g.Bt + (size_t)cur.pn * tstep;
    S.a_ready(cur);
    PG8_STAGE(PG8_SB(0, 0), cB, voffB); PG8_STAGE(PG8_SA(0, 0), cA, voffA); PG8_STAGE(PG8_SB(0, 1), cB + hstep, voffB); PG8_STAGE(PG8_SA(0, 1), cA + hstep, voffA);
    if (wr == 1) PG8_BAR;
    PG8_WAIT_V(4); PG8_BAR;
    PG8_STAGE(PG8_SB(1, 0), cB + kstep, voffB); PG8_STAGE(PG8_SA(1, 0), cA + kstep, voffA); PG8_STAGE(PG8_SB(1, 1), cB + hstep + kstep, voffB);
    PG8_WAIT_V(6); PG8_BAR;
    PG8_STAMP();
    for (;;) {
        const bool has_next = S.next(ui + 1, nxt);
        const char* nA = has_next ? (const char*)g.A + (size_t)nxt.pm * tstep : cA; const char* nB = has_next ? (const char*)g.Bt + (size_t)nxt.pn * tstep : cB;
        for (int t = 0; t < nt; t += 2) {
            const bool last = (t == nt - 2);
            const char* a1 = cA + (size_t)(t + 1) * kstep;
            const char* a2 = last ? nA : cA + (size_t)(t + 2) * kstep; const char* b2 = last ? nB : cB + (size_t)(t + 2) * kstep;
            const char* a3 = a2 + kstep; const char* b3 = b2 + kstep;
            if (last && has_next) S.a_ready(nxt);
            PG8_LDB(B0, 0, 0); PG8_SCHED; PG8_LDA(At, 0, 0); PG8_STAGE(PG8_SA(1, 1), a1 + hstep, voffA);
            PG8_WAIT_L(8); PG8_BAR; PG8_WAIT_L(0); PG8_MMA(0, 0, At, B0); PG8_BAR; PG8_SCHED;
            PG8_LDB(B1, 0, 1); PG8_STAGE(PG8_SB(0, 0), b2, voffB);
            PG8_BAR; PG8_WAIT_L(0); PG8_MMA(0, 1, At, B1); PG8_BAR;
            PG8_LDA(At, 0, 1); PG8_STAGE(PG8_SA(0, 0), a2, voffA);
            PG8_BAR; PG8_WAIT_L(0); PG8_MMA(1, 0, At, B0); PG8_BAR; PG8_SCHED;
            PG8_STAGE(PG8_SB(0, 1), b2 + hstep, voffB);
            PG8_WAIT_V(6); PG8_BAR; PG8_MMA(1, 1, At, B1); PG8_BAR;
            PG8_LDB(B0, 1, 0); PG8_SCHED; PG8_LDA(At, 1, 0); PG8_STAGE(PG8_SA(0, 1), a2 + hstep, voffA);
            PG8_WAIT_L(8); PG8_BAR; PG8_WAIT_L(0); PG8_MMA(0, 0, At, B0); PG8_BAR; PG8_SCHED;
            PG8_LDB(B1, 1, 1); PG8_STAGE(PG8_SB(1, 0), b3, voffB);
            PG8_BAR; PG8_WAIT_L(0); PG8_MMA(0, 1, At, B1); PG8_BAR;
            PG8_LDA(At, 1, 1); PG8_STAGE(PG8_SA(1, 0), a3, voffA);
            PG8_BAR; PG8_WAIT_L(0); PG8_MMA(1, 0, At, B0); PG8_BAR; PG8_SCHED;
            PG8_STAGE(PG8_SB(1, 1), b3 + hstep, voffB);
            PG8_WAIT_V(6); PG8_BAR; PG8_MMA(1, 1, At, B1); PG8_BAR;
        }
        PG8_STAMP();
        if constexpr (!Epi::AFTER_DRAIN) { E(acc, cur, wr, wc, fr, fq); S.done(cur); }
        PG8_STAMP();
        if (!has_next) break;
#pragma unroll
        for (int a = 0; a < 2; ++a)
#pragma unroll
            for (int b = 0; b < 2; ++b)
#pragma unroll
                for (int m = 0; m < 4; ++m)
#pragma unroll
                    for (int n = 0; n < 2; ++n) acc[a][b][m][n] = (f32x4){0.f, 0.f, 0.f, 0.f};
        cur = nxt; cA = nA; cB = nB; ++ui;
    }
    PG8_WAIT_V(0);
    if (wr == 0) PG8_BAR;
    PG8_BAR;
    if constexpr (Epi::AFTER_DRAIN) { E.fused(acc, cur, wr, wc, fr, fq, lds, wid, lane); S.done(cur); }
    PG8_STAMP();
    if (STAMP && wid == 0) { stamps[lane] = lane < nts ? (((unsigned long long)(unsigned)ts_hi << 32) | (unsigned)ts_lo) : 0ull;
        if (lane == 62) stamps[62] = rt_entry; if (lane == 63) stamps[63] = (unsigned long long)wall_clock64(); }
#undef PG8_STAMP
#undef PG8_SA
#undef PG8_SB
#undef PG8_STAGE
#undef PG8_LDA
#undef PG8_LDB
#undef PG8_MMA
#undef PG8_WAIT_V
#undef PG8_WAIT_L
#undef PG8_BAR
#undef PG8_SCHED
}
}

namespace cg = cooperative_groups;
typedef unsigned short bf16_t;
typedef short bf16x8 __attribute__((ext_vector_type(8)));
typedef short bf16x4 __attribute__((ext_vector_type(4)));
typedef float f32x4 __attribute__((ext_vector_type(4)));
typedef unsigned u32x4 __attribute__((ext_vector_type(4)));
typedef unsigned u32x2 __attribute__((ext_vector_type(2)));

constexpr int TP = 65536, TS = 512, TT = TP + TS;
constexpr int DM = 1024;
constexpr int NTHR = 512;
constexpr int LDS_BYTES = 131072;
constexpr int NIN = 7936;
constexpr int IN_W = 9760;

constexpr size_t O_YP = 0, O_YS = 67108864, O_KP = 67633152, O_VP = 67895296, O_CP = 68157440, O_SP = 68231168,
                 O_KS = 70328320, O_VS = 70459392, O_CS = 70590464, O_SS = 70737920;
constexpr size_t SZ1K = (size_t)TT * 1024 * 2;
constexpr size_t W_Q = 0, W_K = W_Q + SZ1K, W_V = W_K + SZ1K / 4, W_G = W_V + SZ1K / 4, W_Z = W_G + SZ1K, W_XBC = W_Z + 2 * SZ1K,
                 W_DT = W_XBC + 3 * SZ1K, W_WIN = W_DT + (size_t)TT * 32 * 4, W_WG = W_WIN + (size_t)NIN * 1024 * 2, W_WAO = W_WG + 2048 * 1024 * 2,
                 W_WSO = W_WAO + 1024 * 1024 * 2, W_WOUT = W_WSO + 1024 * 2048 * 2, W_ROPE = W_WOUT + 1024 * 1024 * 2,
                 W_SSQG = W_ROPE + 8224 * 8 * 8, W_SSQO = W_SSQG + (size_t)TT * 32 * 4, W_BAR = W_SSQO + (size_t)TT * 16 * 4, W_END = W_BAR + 1024;
constexpr size_t W_GA = W_XBC, W_GS = W_XBC + SZ1K, W_MG = W_XBC + 2 * SZ1K;
static_assert(W_END <= (size_t)1073741824, "workspace");

struct Params {
    const float *x_prompt, *x_sample, *cache_k, *cache_v, *state_conv, *state_ssm, *pre_norm_w, *w_in, *conv_w, *conv_b, *dt_bias, *a_log, *d_skip,
        *sinks, *ssm_norm_w, *w_attn_o, *w_ssm_o, *w_out, *post_norm_w;
    float* out; unsigned char* ws; int ph_lo, ph_hi; unsigned long long ws_size; int dbg, pad;
};

__device__ __forceinline__ unsigned short f2bf(float f) { unsigned u = __float_as_uint(f); u += 0x7FFFu + ((u >> 16) & 1u); return (unsigned short)(u >> 16); }
__device__ __forceinline__ float bf2f(unsigned short b) { return __uint_as_float(((unsigned)b) << 16); }
__device__ __forceinline__ float bf2f_s(short b) { return __uint_as_float(((unsigned)(unsigned short)b) << 16); }
__device__ __forceinline__ unsigned pk2(float lo, float hi) { return pg8::cvt_pk_bf16(lo, hi); }
__device__ __forceinline__ float sigmoidf_(float x) { return __builtin_amdgcn_rcpf(1.0f + __expf(-x)); }
__device__ __forceinline__ float siluf_(float x) { return x * __builtin_amdgcn_rcpf(1.0f + __expf(-x)); }
__device__ __forceinline__ void unpack8(const u32x4 w, float (&v)[8]) {
    v[0] = __uint_as_float(w.x << 16); v[1] = __uint_as_float(w.x & 0xffff0000u); v[2] = __uint_as_float(w.y << 16); v[3] = __uint_as_float(w.y & 0xffff0000u);
    v[4] = __uint_as_float(w.z << 16); v[5] = __uint_as_float(w.z & 0xffff0000u); v[6] = __uint_as_float(w.w << 16); v[7] = __uint_as_float(w.w & 0xffff0000u);
}
__device__ __forceinline__ u32x4 pack8(const float (&v)[8]) { u32x4 w; w.x = pk2(v[0], v[1]); w.y = pk2(v[2], v[3]); w.z = pk2(v[4], v[5]); w.w = pk2(v[6], v[7]); return w; }

__device__ __forceinline__ void transpose_tile(unsigned char* lds, const float* src, int ld, int col0, int ncols_valid, int k0, bf16_t* dst, int dstK, int n0, const float* kscale) {
    float* tile = (float*)lds;
    const int tid = threadIdx.x;
    const int kk = tid >> 4, c4 = (tid & 15) * 4;
#pragma unroll
    for (int pass = 0; pass < 2; ++pass) {
        const int k = kk + pass * 32;
        float4 v = make_float4(0.f, 0.f, 0.f, 0.f);
        if (c4 < ncols_valid) v = *(const float4*)(src + (size_t)(k0 + k) * ld + col0 + c4);
        if (kscale) { const float s = kscale[k0 + k]; v.x *= s; v.y *= s; v.z *= s; v.w *= s; }
        tile[k * 65 + c4 + 0] = v.x; tile[k * 65 + c4 + 1] = v.y; tile[k * 65 + c4 + 2] = v.z; tile[k * 65 + c4 + 3] = v.w;
    }
    __syncthreads();
    const int n = tid >> 3, kg = tid & 7;
    float v[8];
#pragma unroll
    for (int j = 0; j < 8; ++j) v[j] = tile[(kg * 8 + j) * 65 + n];
    *(u32x4*)(dst + (size_t)(n0 + n) * dstK + k0 + kg * 8) = pack8(v);
    __syncthreads();
}

__device__ __forceinline__ void p0_prologue(const Params& p, unsigned char* lds) {
    const int tid = threadIdx.x, lane = tid & 63, wave = tid >> 6;
    const int G = gridDim.x, bid = blockIdx.x;
    bf16_t* H = (bf16_t*)p.out;
    { float4 wv[4];
#pragma unroll
      for (int i = 0; i < 4; ++i) wv[i] = *(const float4*)(p.pre_norm_w + i * 256 + lane * 4);
      float4 v[2][4], nv[2][4];
      const int tstep = 2 * G * 8;
#define P0_LOAD(dst, tb_) do { _Pragma("unroll") for (int k = 0; k < 2; ++k) { const int t_ = (tb_) + k * G * 8; const int tt_ = t_ < TT ? t_ : TT - 1; \
          const float* xr_ = tt_ < TP ? p.x_prompt + (size_t)tt_ * DM : p.x_sample + (size_t)(tt_ - TP) * DM; \
          _Pragma("unroll") for (int i = 0; i < 4; ++i) dst[k][i] = *(const float4*)(xr_ + i * 256 + lane * 4); } } while (0)
      int tb = bid * 8 + wave;
      if (tb < TT) P0_LOAD(v, tb);
      for (; tb < TT; tb += tstep) {
        if (tb + tstep < TT) P0_LOAD(nv, tb + tstep);
#pragma unroll
        for (int k = 0; k < 2; ++k) { const int t = tb + k * G * 8; if (t < TT) {
            float ss = 0.f;
#pragma unroll
            for (int i = 0; i < 4; ++i) ss += v[k][i].x * v[k][i].x + v[k][i].y * v[k][i].y + v[k][i].z * v[k][i].z + v[k][i].w * v[k][i].w;
#pragma unroll
            for (int o = 32; o >= 1; o >>= 1) ss += __shfl_xor(ss, o);
            const float r = rsqrtf(ss * (1.0f / 1024.0f) + 1e-6f);
#pragma unroll
            for (int i = 0; i < 4; ++i) { u32x2 o; o.x = pk2(v[k][i].x * r * wv[i].x, v[k][i].y * r * wv[i].y); o.y = pk2(v[k][i].z * r * wv[i].z, v[k][i].w * r * wv[i].w);
                *(u32x2*)(H + (size_t)t * DM + i * 256 + lane * 4) = o; } } }
#pragma unroll
        for (int k = 0; k < 2; ++k)
#pragma unroll
            for (int i = 0; i < 4; ++i) v[k][i] = nv[k][i];
      }
#undef P0_LOAD
    }
    bf16_t* WIN = (bf16_t*)(p.ws + W_WIN); bf16_t* WG = (bf16_t*)(p.ws + W_WG); bf16_t* WAO = (bf16_t*)(p.ws + W_WAO);
    bf16_t* WSO = (bf16_t*)(p.ws + W_WSO); bf16_t* WOUT = (bf16_t*)(p.ws + W_WOUT);
    constexpr int J0 = 1920, J1 = J0 + 16, J2 = J1 + 512, J3 = J2 + 256, J4 = J3 + 512, J5 = J4 + 256;
    {
        float* tile = (float*)lds;
        const int kk = tid >> 4, c4 = (tid & 15) * 4, tn = tid >> 3, tkg = tid & 7;
        const float* src = nullptr; int ld = 0, col0 = 0, valid = 0, k0 = 0, dstK = 0, n0 = 0; bf16_t* dst = nullptr; const float* kscale = nullptr;
#define TJ_DECODE(j) do { \
        if ((j) < J0) { const int nt = (j) >> 4, kt = (j) & 15; src = p.w_in; ld = IN_W; col0 = nt * 64; valid = 64; k0 = kt * 64; dst = WIN; dstK = 1024; n0 = nt * 64; kscale = nullptr; } \
        else if ((j) < J1) { const int kt = (j) - J0; src = p.w_in; ld = IN_W; col0 = 7680; valid = 32; k0 = kt * 64; dst = WIN; dstK = 1024; n0 = 7680; kscale = nullptr; } \
        else if ((j) < J2) { const int jj = (j) - J1, nt = jj >> 4, kt = jj & 15; src = p.w_in; ld = IN_W; col0 = 7712 + nt * 64; valid = 64; k0 = kt * 64; dst = WG; dstK = 1024; n0 = nt * 64; kscale = nullptr; } \
        else if ((j) < J3) { const int jj = (j) - J2, nt = jj >> 4, kt = jj & 15; src = p.w_attn_o; ld = 1024; col0 = nt * 64; valid = 64; k0 = kt * 64; dst = WAO; dstK = 1024; n0 = nt * 64; kscale = nullptr; } \
        else if ((j) < J4) { const int jj = (j) - J3, nt = jj >> 5, kt = jj & 31; src = p.w_ssm_o; ld = 1024; col0 = nt * 64; valid = 64; k0 = kt * 64; dst = WSO; dstK = 2048; n0 = nt * 64; kscale = p.ssm_norm_w; } \
        else { const int jj = (j) - J4, nt = jj >> 4, kt = jj & 15; src = p.w_out; ld = 1024; col0 = nt * 64; valid = 64; k0 = kt * 64; dst = WOUT; dstK = 1024; n0 = nt * 64; kscale = nullptr; } } while (0)
#define TJ_LOAD() do { _Pragma("unroll") for (int ps = 0; ps < 2; ++ps) { const int k = kk + ps * 32; float4 v_ = make_float4(0.f, 0.f, 0.f, 0.f); \
            if (c4 < valid) v_ = *(const float4*)(src + (size_t)(k0 + k) * ld + col0 + c4); \
            if (kscale) { const float s_ = kscale[k0 + k]; v_.x *= s_; v_.y *= s_; v_.z *= s_; v_.w *= s_; } tv[ps] = v_; } } while (0)
        float4 tv[2];
        int j = bid;
        if (j < J5) { TJ_DECODE(j); TJ_LOAD(); }
        for (; j < J5; j += G) {
#pragma unroll
            for (int ps = 0; ps < 2; ++ps) { const int k = kk + ps * 32; tile[k * 65 + c4 + 0] = tv[ps].x; tile[k * 65 + c4 + 1] = tv[ps].y; tile[k * 65 + c4 + 2] = tv[ps].z; tile[k * 65 + c4 + 3] = tv[ps].w; }
            __syncthreads();
            bf16_t* const dptr = dst + (size_t)(n0 + tn) * dstK + k0 + tkg * 8;
            if (j + G < J5) { TJ_DECODE(j + G); TJ_LOAD(); }
            float v[8];
#pragma unroll
            for (int e = 0; e < 8; ++e) v[e] = tile[(tkg * 8 + e) * 65 + tn];
            *(u32x4*)dptr = pack8(v);
            __syncthreads();
        }
#undef TJ_DECODE
#undef TJ_LOAD
    }
    const size_t gtid = (size_t)bid * NTHR + tid, gstride = (size_t)G * NTHR;
    { u32x4* z = (u32x4*)(WIN + (size_t)7744 * 1024); const size_t n16 = (size_t)192 * 1024 * 2 / 16; const u32x4 zero = {0u, 0u, 0u, 0u};
      for (size_t i = gtid; i < n16; i += gstride) z[i] = zero; }
    { float2* rope = (float2*)(p.ws + W_ROPE);
      for (size_t i = gtid; i < 8224 * 8; i += gstride) { const int pi = (int)(i >> 3), j = (int)(i & 7); const int pos = pi < 8192 ? pi : 2048 + (pi - 8192);
          const float inv = (float)pow(500000.0, -(double)j / 8.0); const float ang = (float)pos * inv; double s, c; sincos((double)ang, &s, &c); rope[i] = make_float2((float)c, (float)s); } }
}

struct EpiInProj {
    static constexpr bool PERM = true, AFTER_DRAIN = false;
    unsigned char* ws; const float* dt_bias;
    __device__ __forceinline__ void operator()(const f32x4 (&acc)[2][2][4][2], const pg8::Unit& u, int wr, int wc, int fr, int fq) const {
        const int pn = u.pn; const int row0 = u.pm * 256 + wr * 64 + fr;
        if (pn == 30) {
            if (wc == 0) { float* DT = (float*)(ws + W_DT);
#pragma unroll
                for (int n = 0; n < 2; ++n) { const f32x4 bv = *(const f32x4*)(dt_bias + 8 * fq + 4 * n);
#pragma unroll
                    for (int ai = 0; ai < 2; ++ai)
#pragma unroll
                        for (int m = 0; m < 4; ++m) { f32x4 v = acc[ai][0][m][n] + bv;
#pragma unroll
                            for (int j = 0; j < 4; ++j) v[j] = v[j] > 20.f ? v[j] : log1pf(__expf(v[j]));
                            *(f32x4*)(DT + (size_t)(row0 + ai * 128 + m * 16) * 32 + 8 * fq + 4 * n) = v; } } }
            return;
        }
        bf16_t* base; int ldc, colt;
        if (pn < 4) { base = (bf16_t*)(ws + W_Q); ldc = 1024; colt = pn * 256; }
        else if (pn == 4) { base = (bf16_t*)(ws + W_K); ldc = 256; colt = 0; }
        else if (pn == 5) { base = (bf16_t*)(ws + W_V); ldc = 256; colt = 0; }
        else if (pn < 10) { base = (bf16_t*)(ws + W_G); ldc = 1024; colt = (pn - 6) * 256; }
        else if (pn < 18) { base = (bf16_t*)(ws + W_Z); ldc = 2048; colt = (pn - 10) * 256; }
        else { base = (bf16_t*)(ws + W_XBC); ldc = 3072; colt = (pn - 18) * 256; }
        const int col0 = colt + wc * 32 + 8 * fq;
#pragma unroll
        for (int ai = 0; ai < 2; ++ai)
#pragma unroll
            for (int m = 0; m < 4; ++m) { bf16_t* rowp = base + (size_t)(row0 + ai * 128 + m * 16) * ldc + col0;
#pragma unroll
                for (int bj = 0; bj < 2; ++bj) { const f32x4 v0 = acc[ai][bj][m][0], v1 = acc[ai][bj][m][1];
                    u32x4 w; w.x = pk2(v0[0], v0[1]); w.y = pk2(v0[2], v0[3]); w.z = pk2(v1[0], v1[1]); w.w = pk2(v1[2], v1[3]);
                    *(u32x4*)(rowp + bj * 128) = w; } }
    }
};
template <int MODE> struct EpiMerge {
    static constexpr bool PERM = true, AFTER_DRAIN = false;
    bf16_t* O; const bf16_t* G1;
    __device__ __forceinline__ void operator()(const f32x4 (&acc)[2][2][4][2], const pg8::Unit& u, int wr, int wc, int fr, int fq) const {
        const int row0 = u.pm * 256 + wr * 64 + fr; const int col0 = u.pn * 256 + wc * 32 + 8 * fq;
#pragma unroll
        for (int ai = 0; ai < 2; ++ai) {
            u32x4 gq[4][2], oq[4][2];
            if (MODE != 0) {
#pragma unroll
                for (int m = 0; m < 4; ++m)
#pragma unroll
                    for (int bj = 0; bj < 2; ++bj) { const size_t off = (size_t)(row0 + ai * 128 + m * 16) * 1024 + col0 + bj * 128;
                        gq[m][bj] = *(const u32x4*)(G1 + off); if (MODE == 2) oq[m][bj] = *(const u32x4*)(O + off); }
            }
#pragma unroll
            for (int m = 0; m < 4; ++m)
#pragma unroll
                for (int bj = 0; bj < 2; ++bj) { const size_t off = (size_t)(row0 + ai * 128 + m * 16) * 1024 + col0 + bj * 128;
                    const f32x4 v0 = acc[ai][bj][m][0], v1 = acc[ai][bj][m][1];
                    float v[8] = {v0[0], v0[1], v0[2], v0[3], v1[0], v1[1], v1[2], v1[3]};
                    if (MODE == 0) {
#pragma unroll
                        for (int j = 0; j < 8; ++j) v[j] = sigmoidf_(v[j]);
                    } else { float g[8]; unpack8(gq[m][bj], g);
                        if (MODE == 1) {
#pragma unroll
                            for (int j = 0; j < 8; ++j) v[j] = g[j] * v[j];
                        } else { float o[8]; unpack8(oq[m][bj], o);
#pragma unroll
                            for (int j = 0; j < 8; ++j) v[j] = o[j] + g[j] * v[j]; } }
                    *(u32x4*)(O + off) = pack8(v); }
        }
    }
};
template <int ADD> struct EpiOutT {
    static constexpr bool PERM = true, AFTER_DRAIN = false;
    bf16_t* out; float* ssq;
    __device__ __forceinline__ void operator()(const f32x4 (&acc)[2][2][4][2], const pg8::Unit& u, int wr, int wc, int fr, int fq) const {
        const int row0 = u.pm * 256 + wr * 64 + fr, col0 = u.pn * 256 + wc * 32 + 8 * fq;
#pragma unroll
        for (int ai = 0; ai < 2; ++ai)
#pragma unroll
            for (int m = 0; m < 4; ++m) { const int row = row0 + ai * 128 + m * 16; bf16_t* rowp = out + (size_t)row * 1024 + col0;
                float s = 0.f;
#pragma unroll
                for (int bj = 0; bj < 2; ++bj) { const f32x4 v0 = acc[ai][bj][m][0], v1 = acc[ai][bj][m][1];
                    float v[8] = {v0[0], v0[1], v0[2], v0[3], v1[0], v1[1], v1[2], v1[3]};
                    if (ADD) { float o[8]; unpack8(*(const u32x4*)(rowp + bj * 128), o);
#pragma unroll
                        for (int j = 0; j < 8; ++j) v[j] += o[j]; }
#pragma unroll
                    for (int j = 0; j < 8; ++j) s += v[j] * v[j];
                    *(u32x4*)(rowp + bj * 128) = pack8(v); }
                s += __shfl_xor(s, 16); s += __shfl_xor(s, 32);
                if (fq == 0) ssq[(size_t)row * 16 + u.pn * 4 + wc] = s; }
    }
};

constexpr int KS_STRIDE = 72;
constexpr int VT_STRIDE = 200;
constexpr int KS_OFF = 0, VT_OFF = 192 * KS_STRIDE * 2;

__device__ __forceinline__ void attn_unit(const Params& p, unsigned char* lds, const int is_sample, const int b, const int c, const int kvh) {
    const int tid = threadIdx.x, lane = tid & 63, wave = tid >> 6, fr = lane & 15, fq = lane >> 4;
    bf16_t* Q = (bf16_t*)(p.ws + W_Q); const bf16_t* K = (const bf16_t*)(p.ws + W_K); const bf16_t* V = (const bf16_t*)(p.ws + W_V);
    const bf16_t* GT = (const bf16_t*)(p.ws + W_G); const float2* rope = (const float2*)(p.ws + W_ROPE);
    bf16_t* Ks = (bf16_t*)(lds + KS_OFF); bf16_t* Vt = (bf16_t*)(lds + VT_OFF);
    int nkeys, ncache, NQ, cs; size_t tq0, tk0; int pos_q0, pos_k0;
    if (is_sample) { nkeys = 160; ncache = 128; NQ = 32; cs = 0; tq0 = (size_t)TP + b * 32; tk0 = tq0; pos_q0 = 8192; pos_k0 = 8192; }
    else { cs = c >= 2 ? c - 2 : 0; nkeys = (c - cs + 1) * 64; ncache = 0; NQ = 64; tq0 = (size_t)b * 8192 + c * 64; tk0 = (size_t)b * 8192 + cs * 64; pos_q0 = c * 64; pos_k0 = cs * 64; }
    __syncthreads();
    for (int item = tid; item < nkeys * 4; item += NTHR) {
        const int key = item >> 2, i = item & 3;
        float v[16];
        if (key < ncache) { const float* src = p.cache_k + ((size_t)(b * 128 + key) * 4 + kvh) * 64 + i * 16;
#pragma unroll
            for (int q4 = 0; q4 < 4; ++q4) { const float4 f = *(const float4*)(src + q4 * 4); v[q4 * 4] = f.x; v[q4 * 4 + 1] = f.y; v[q4 * 4 + 2] = f.z; v[q4 * 4 + 3] = f.w; }
        } else {
            const int kk = key - ncache; const bf16_t* src = K + (tk0 + kk) * 256 + kvh * 64 + i * 16;
            float a[8], bb[8]; unpack8(*(const u32x4*)src, a); unpack8(*(const u32x4*)(src + 8), bb);
            if (i == 0) { const float2* rp = rope + (size_t)(pos_k0 + kk) * 8;
#pragma unroll
                for (int j = 0; j < 8; ++j) { const float2 cssn = rp[j]; v[j] = a[j] * cssn.x - bb[j] * cssn.y; v[8 + j] = bb[j] * cssn.x + a[j] * cssn.y; }
            } else {
#pragma unroll
                for (int j = 0; j < 8; ++j) { v[j] = a[j]; v[8 + j] = bb[j]; } }
            float* dst = nullptr;
            if (is_sample) dst = p.out + O_KS + ((size_t)(b * 32 + kk) * 4 + kvh) * 64 + i * 16;
            else if (c >= 126 && kk >= (c - cs) * 64) dst = p.out + O_KP + ((size_t)(b * 128 + (c - 126) * 64 + (kk - (c - cs) * 64)) * 4 + kvh) * 64 + i * 16;
            if (dst) {
#pragma unroll
                for (int q4 = 0; q4 < 4; ++q4) *(float4*)(dst + q4 * 4) = make_float4(v[q4 * 4], v[q4 * 4 + 1], v[q4 * 4 + 2], v[q4 * 4 + 3]); }
        }
        float lo[8], hi[8];
#pragma unroll
        for (int j = 0; j < 8; ++j) { lo[j] = v[j]; hi[j] = v[8 + j]; }
        *(u32x4*)(Ks + key * KS_STRIDE + i * 16) = pack8(lo); *(u32x4*)(Ks + key * KS_STRIDE + i * 16 + 8) = pack8(hi);
    }
    for (int item = tid; item < nkeys * 8; item += NTHR) {
        const int dg = item / nkeys, key = item - dg * nkeys;
        float v[8];
        if (key < ncache) { const float* src = p.cache_v + ((size_t)(b * 128 + key) * 4 + kvh) * 64 + dg * 8;
            const float4 f0 = *(const float4*)src, f1 = *(const float4*)(src + 4); v[0] = f0.x; v[1] = f0.y; v[2] = f0.z; v[3] = f0.w; v[4] = f1.x; v[5] = f1.y; v[6] = f1.z; v[7] = f1.w;
        } else {
            const int kk = key - ncache; unpack8(*(const u32x4*)(V + (tk0 + kk) * 256 + kvh * 64 + dg * 8), v);
            float* dst = nullptr;
            if (is_sample) dst = p.out + O_VS + ((size_t)(b * 32 + kk) * 4 + kvh) * 64 + dg * 8;
            else if (c >= 126 && kk >= (c - cs) * 64) dst = p.out + O_VP + ((size_t)(b * 128 + (c - 126) * 64 + (kk - (c - cs) * 64)) * 4 + kvh) * 64 + dg * 8;
            if (dst) { *(float4*)dst = make_float4(v[0], v[1], v[2], v[3]); *(float4*)(dst + 4) = make_float4(v[4], v[5], v[6], v[7]); }
        }
#pragma unroll
        for (int e = 0; e < 8; ++e) Vt[(dg * 8 + e) * VT_STRIDE + key] = f2bf(v[e]);
    }
    __syncthreads();
    const int nqt_h = NQ >> 4, nqt = 4 * nqt_h, nkt = nkeys >> 4;
    for (int qt = wave; qt < nqt; qt += 8) {
        const int g = qt / nqt_h, r0 = (qt - g * nqt_h) * 16, hq = kvh * 4 + g;
        bf16_t* qp = Q + (tq0 + r0 + fr) * 1024 + hq * 64 + fq * 8;
        bf16x8 q0 = *(const bf16x8*)qp, q1 = *(const bf16x8*)(qp + 32);
        { const float2* rp = rope + (size_t)(pos_q0 + r0 + fr) * 8;
#pragma unroll
          for (int j = 0; j < 8; ++j) { const float mine = bf2f_s(q0[j]); const float other = __shfl_xor(mine, 16); const float2 cssn = rp[j];
              const float nv = (fq == 0) ? mine * cssn.x - other * cssn.y : mine * cssn.x + other * cssn.y;
              if (fq < 2) q0[j] = (short)f2bf(nv); } }
        f32x4 sacc[12];
#pragma unroll
        for (int kt = 0; kt < 12; ++kt) { sacc[kt] = (f32x4){0.f, 0.f, 0.f, 0.f};
            if (kt < nkt) { const bf16_t* kp = Ks + (kt * 16 + fr) * KS_STRIDE + fq * 8;
                sacc[kt] = __builtin_amdgcn_mfma_f32_16x16x32_bf16(*(const bf16x8*)kp, q0, sacc[kt], 0, 0, 0);
                sacc[kt] = __builtin_amdgcn_mfma_f32_16x16x32_bf16(*(const bf16x8*)(kp + 32), q1, sacc[kt], 0, 0, 0); } }
        const float sk = p.sinks[hq];
        float m = sk;
#pragma unroll
        for (int kt = 0; kt < 12; ++kt) if (kt < nkt) {
#pragma unroll
            for (int r = 0; r < 4; ++r) { sacc[kt][r] *= 0.125f; m = fmaxf(m, sacc[kt][r]); } }
        m = fmaxf(m, __shfl_xor(m, 16)); m = fmaxf(m, __shfl_xor(m, 32));
        float sum = 0.f;
#pragma unroll
        for (int kt = 0; kt < 12; ++kt) if (kt < nkt) {
#pragma unroll
            for (int r = 0; r < 4; ++r) { const float e = __expf(sacc[kt][r] - m); sacc[kt][r] = e; sum += e; } }
        sum += __shfl_xor(sum, 16); sum += __shfl_xor(sum, 32);
        const float inv = 1.0f / (sum + __expf(sk - m));
        f32x4 oacc[4];
#pragma unroll
        for (int dt = 0; dt < 4; ++dt) oacc[dt] = (f32x4){0.f, 0.f, 0.f, 0.f};
#pragma unroll
        for (int kk = 0; kk < 6; ++kk) if (2 * kk < nkt) {
            union { bf16x8 v; unsigned u[4]; } pb;
            pb.u[0] = pk2(sacc[2 * kk][0], sacc[2 * kk][1]); pb.u[1] = pk2(sacc[2 * kk][2], sacc[2 * kk][3]);
            pb.u[2] = pk2(sacc[2 * kk + 1][0], sacc[2 * kk + 1][1]); pb.u[3] = pk2(sacc[2 * kk + 1][2], sacc[2 * kk + 1][3]);
#pragma unroll
            for (int dt = 0; dt < 4; ++dt) { const bf16_t* vp = Vt + (dt * 16 + fr) * VT_STRIDE + kk * 32 + fq * 4;
                union { bf16x8 v; u32x2 h[2]; } va; va.h[0] = *(const u32x2*)vp; va.h[1] = *(const u32x2*)(vp + 16);
                oacc[dt] = __builtin_amdgcn_mfma_f32_16x16x32_bf16(va.v, pb.v, oacc[dt], 0, 0, 0); } }
#pragma unroll
        for (int dt = 0; dt < 4; ++dt) { const size_t off = (tq0 + r0 + fr) * 1024 + hq * 64 + dt * 16 + fq * 4;
            const u32x2 gw = *(const u32x2*)(GT + off);
            const float g0 = __uint_as_float(gw.x << 16), g1 = __uint_as_float(gw.x & 0xffff0000u), g2 = __uint_as_float(gw.y << 16), g3 = __uint_as_float(gw.y & 0xffff0000u);
            u32x2 o; o.x = pk2(oacc[dt][0] * inv * siluf_(g0), oacc[dt][1] * inv * siluf_(g1)); o.y = pk2(oacc[dt][2] * inv * siluf_(g2), oacc[dt][3] * inv * siluf_(g3));
            *(u32x2*)(Q + off) = o; }
    }
}

constexpr int K2_SLOT = 64 * KS_STRIDE;
constexpr int V2_STRIDE = 264;
constexpr int K2_OFF = 0, V2_OFF = 4 * K2_SLOT * 2;

__device__ __forceinline__ void attn_run(const Params& p, unsigned char* lds, const int b, const int kvh, const int c0) {
    const int tid = threadIdx.x, lane = tid & 63, wave = tid >> 6, fr = lane & 15, fq = lane >> 4;
    bf16_t* Q = (bf16_t*)(p.ws + W_Q); const bf16_t* K = (const bf16_t*)(p.ws + W_K); const bf16_t* V = (const bf16_t*)(p.ws + W_V);
    const bf16_t* GT = (const bf16_t*)(p.ws + W_G); const float2* rope = (const float2*)(p.ws + W_ROPE);
    bf16_t* Ks = (bf16_t*)(lds + K2_OFF); bf16_t* Vt = (bf16_t*)(lds + V2_OFF);
    const int kkey = tid >> 2, ki = tid & 3;
    const int vkey = tid & 63, vdg = tid >> 6;
    const size_t tb0 = (size_t)b * 8192;
    u32x4 rka = {0u, 0u, 0u, 0u}, rkb = rka, rv = rka; f32x4 rkr[4];
#pragma unroll
    for (int j = 0; j < 4; ++j) rkr[j] = (f32x4){1.f, 0.f, 1.f, 0.f};
#define A2_LOAD(cc) do { if (tid < 256) { const bf16_t* s_ = K + (tb0 + (size_t)(cc) * 64 + kkey) * 256 + kvh * 64 + ki * 16; rka = *(const u32x4*)s_; rkb = *(const u32x4*)(s_ + 8); \
            if (ki == 0) { const f32x4* rp4_ = (const f32x4*)(rope + (size_t)((cc) * 64 + kkey) * 8); _Pragma("unroll") for (int j = 0; j < 4; ++j) rkr[j] = rp4_[j]; } } \
        rv = *(const u32x4*)(V + (tb0 + (size_t)(cc) * 64 + vkey) * 256 + kvh * 64 + vdg * 8); } while (0)
#define A2_WRITE(cc) do { const int sl_ = (cc) & 3; \
        if (tid < 256) { float a_[8], b_[8]; unpack8(rka, a_); unpack8(rkb, b_); \
            if (ki == 0) { \
                _Pragma("unroll") for (int j = 0; j < 8; ++j) { const float cc_ = rkr[j >> 1][(j & 1) * 2], ss_ = rkr[j >> 1][(j & 1) * 2 + 1]; const float x1_ = a_[j], x2_ = b_[j]; a_[j] = x1_ * cc_ - x2_ * ss_; b_[j] = x2_ * cc_ + x1_ * ss_; } } \
            if ((cc) >= 126) { float* d_ = p.out + O_KP + ((size_t)(b * 128 + ((cc) - 126) * 64 + kkey) * 4 + kvh) * 64 + ki * 16; \
                *(float4*)d_ = make_float4(a_[0], a_[1], a_[2], a_[3]); *(float4*)(d_ + 4) = make_float4(a_[4], a_[5], a_[6], a_[7]); *(float4*)(d_ + 8) = make_float4(b_[0], b_[1], b_[2], b_[3]); *(float4*)(d_ + 12) = make_float4(b_[4], b_[5], b_[6], b_[7]); } \
            *(u32x4*)(Ks + sl_ * K2_SLOT + kkey * KS_STRIDE + ki * 16) = pack8(a_); *(u32x4*)(Ks + sl_ * K2_SLOT + kkey * KS_STRIDE + ki * 16 + 8) = pack8(b_); } \
        { if ((cc) >= 126) { float v_[8]; unpack8(rv, v_); float* d_ = p.out + O_VP + ((size_t)(b * 128 + ((cc) - 126) * 64 + vkey) * 4 + kvh) * 64 + vdg * 8; \
              *(float4*)d_ = make_float4(v_[0], v_[1], v_[2], v_[3]); *(float4*)(d_ + 4) = make_float4(v_[4], v_[5], v_[6], v_[7]); } \
          const unsigned vw_[4] = {rv.x, rv.y, rv.z, rv.w}; \
          _Pragma("unroll") for (int e = 0; e < 8; ++e) Vt[(vdg * 8 + e) * V2_STRIDE + sl_ * 64 + vkey] = (bf16_t)((e & 1) ? (vw_[e >> 1] >> 16) : (vw_[e >> 1] & 0xffffu)); } } while (0)
    __syncthreads();
    for (int cc = c0 - 2; cc <= c0; ++cc) if (cc >= 0) { A2_LOAD(cc); A2_WRITE(cc); }
    if (c0 + 1 < 128) A2_LOAD(c0 + 1);
    for (int u = 0; u < 16; ++u) {
        const int c = c0 + u;
        __syncthreads();
        const size_t tq0 = tb0 + (size_t)c * 64;
        bf16x8 q0v[2], q1v[2]; f32x4 csv[2][4];
#pragma unroll
        for (int qi = 0; qi < 2; ++qi) { const int qt = wave * 2 + qi; const bf16_t* qp = Q + (tq0 + (qt & 3) * 16 + fr) * 1024 + (kvh * 4 + (qt >> 2)) * 64 + fq * 8; q0v[qi] = *(const bf16x8*)qp; q1v[qi] = *(const bf16x8*)(qp + 32);
            const f32x4* rp4 = (const f32x4*)(rope + (size_t)(c * 64 + (qt & 3) * 16 + fr) * 8);
#pragma unroll
            for (int j = 0; j < 4; ++j) csv[qi][j] = rp4[j]; }
        if (u + 1 < 16) A2_WRITE(c + 1);
        if (u + 2 < 16) A2_LOAD(c + 2);
#pragma unroll
        for (int qi = 0; qi < 2; ++qi) {
            const int qt = wave * 2 + qi, g = qt >> 2, r0 = (qt & 3) * 16, hq = kvh * 4 + g;
            bf16x8 q0 = q0v[qi], q1 = q1v[qi];
            u32x2 gw[4];
#pragma unroll
            for (int dt = 0; dt < 4; ++dt) gw[dt] = *(const u32x2*)(GT + (tq0 + r0 + fr) * 1024 + hq * 64 + dt * 16 + fq * 4);
            {
#pragma unroll
              for (int j = 0; j < 8; ++j) { const float mine = bf2f_s(q0[j]); const float other = __shfl_xor(mine, 16); const float cs_c = csv[qi][j >> 1][(j & 1) * 2], cs_s = csv[qi][j >> 1][(j & 1) * 2 + 1];
                  const float nv = (fq == 0) ? mine * cs_c - other * cs_s : mine * cs_c + other * cs_s;
                  if (fq < 2) q0[j] = (short)f2bf(nv); } }
            f32x4 sacc[12];
#pragma unroll
            for (int kt = 0; kt < 12; ++kt) { sacc[kt] = (f32x4){0.f, 0.f, 0.f, 0.f}; const int cc = c - 2 + (kt >> 2);
                if (cc >= 0) { const bf16_t* kp = Ks + (cc & 3) * K2_SLOT + ((kt & 3) * 16 + fr) * KS_STRIDE + fq * 8;
                    sacc[kt] = __builtin_amdgcn_mfma_f32_16x16x32_bf16(*(const bf16x8*)kp, q0, sacc[kt], 0, 0, 0);
                    sacc[kt] = __builtin_amdgcn_mfma_f32_16x16x32_bf16(*(const bf16x8*)(kp + 32), q1, sacc[kt], 0, 0, 0); } }
            const float sk = p.sinks[hq];
            float m = sk;
#pragma unroll
            for (int kt = 0; kt < 12; ++kt) if (c - 2 + (kt >> 2) >= 0) {
#pragma unroll
                for (int r = 0; r < 4; ++r) { sacc[kt][r] *= 0.125f; m = fmaxf(m, sacc[kt][r]); } }
            m = fmaxf(m, __shfl_xor(m, 16)); m = fmaxf(m, __shfl_xor(m, 32));
            float sum = 0.f;
#pragma unroll
            for (int kt = 0; kt < 12; ++kt) if (c - 2 + (kt >> 2) >= 0) {
#pragma unroll
                for (int r = 0; r < 4; ++r) { const float e = __expf(sacc[kt][r] - m); sacc[kt][r] = e; sum += e; } }
            sum += __shfl_xor(sum, 16); sum += __shfl_xor(sum, 32);
            const float inv = 1.0f / (sum + __expf(sk - m));
            f32x4 oacc[4];
#pragma unroll
            for (int dt = 0; dt < 4; ++dt) oacc[dt] = (f32x4){0.f, 0.f, 0.f, 0.f};
#pragma unroll
            for (int kk = 0; kk < 6; ++kk) { const int cc = c - 2 + (kk >> 1); if (cc >= 0) {
                union { bf16x8 v; unsigned u[4]; } pb;
                pb.u[0] = pk2(sacc[2 * kk][0], sacc[2 * kk][1]); pb.u[1] = pk2(sacc[2 * kk][2], sacc[2 * kk][3]);
                pb.u[2] = pk2(sacc[2 * kk + 1][0], sacc[2 * kk + 1][1]); pb.u[3] = pk2(sacc[2 * kk + 1][2], sacc[2 * kk + 1][3]);
#pragma unroll
                for (int dt = 0; dt < 4; ++dt) { const bf16_t* vp = Vt + (dt * 16 + fr) * V2_STRIDE + (cc & 3) * 64 + (kk & 1) * 32 + fq * 4;
                    union { bf16x8 v; u32x2 h[2]; } va; va.h[0] = *(const u32x2*)vp; va.h[1] = *(const u32x2*)(vp + 16);
                    oacc[dt] = __builtin_amdgcn_mfma_f32_16x16x32_bf16(va.v, pb.v, oacc[dt], 0, 0, 0); } } }
#pragma unroll
            for (int dt = 0; dt < 4; ++dt) { const size_t off = (tq0 + r0 + fr) * 1024 + hq * 64 + dt * 16 + fq * 4;
                const float g0 = __uint_as_float(gw[dt].x << 16), g1 = __uint_as_float(gw[dt].x & 0xffff0000u), g2 = __uint_as_float(gw[dt].y << 16), g3 = __uint_as_float(gw[dt].y & 0xffff0000u);
                u32x2 o; o.x = pk2(oacc[dt][0] * inv * siluf_(g0), oacc[dt][1] * inv * siluf_(g1)); o.y = pk2(oacc[dt][2] * inv * siluf_(g2), oacc[dt][3] * inv * siluf_(g3));
                *(u32x2*)(Q + off) = o; }
        }
    }
#undef A2_LOAD
#undef A2_WRITE
}

__device__ __forceinline__ void grid_bar(unsigned* word, unsigned G);
typedef unsigned u32x3 __attribute__((ext_vector_type(3)));
__device__ __forceinline__ void unpack6(const u32x3 w, float (&v)[6]) {
    v[0] = __uint_as_float(w.x << 16); v[1] = __uint_as_float(w.x & 0xffff0000u); v[2] = __uint_as_float(w.y << 16); v[3] = __uint_as_float(w.y & 0xffff0000u); v[4] = __uint_as_float(w.z << 16); v[5] = __uint_as_float(w.z & 0xffff0000u);
}
__device__ __forceinline__ void conv_rows(bf16_t* rowp0, const int nrows, float (&w0)[6], float (&w1)[6], float (&w2)[6], const float (&cwt)[4][6], const float (&cb)[6], float* tail_dst) {
    u32x3 cur[8], n1[8], n2[8];
#pragma unroll
    for (int k = 0; k < 8; ++k) { cur[k] = *(const u32x3*)(rowp0 + (size_t)k * 3072); n1[k] = *(const u32x3*)(rowp0 + (size_t)(8 + k) * 3072); }
    for (int r4 = 0; r4 < nrows; r4 += 8) {
        const bool more = r4 + 16 < nrows;
#pragma unroll
        for (int k = 0; k < 8; ++k) n2[k] = more ? *(const u32x3*)(rowp0 + (size_t)(r4 + 16 + k) * 3072) : n1[k];
#pragma unroll
        for (int k = 0; k < 8; ++k) {
            float x3[6]; unpack6(cur[k], x3);
            if (tail_dst && r4 + k >= nrows - 3) { float* d = tail_dst + (size_t)(r4 + k - (nrows - 3)) * 3072; *(float2*)d = make_float2(x3[0], x3[1]); *(float2*)(d + 2) = make_float2(x3[2], x3[3]); *(float2*)(d + 4) = make_float2(x3[4], x3[5]); }
            float y[6];
#pragma unroll
            for (int e = 0; e < 6; ++e) { y[e] = cb[e] + cwt[0][e] * w0[e] + cwt[1][e] * w1[e] + cwt[2][e] * w2[e] + cwt[3][e] * x3[e]; y[e] = siluf_(y[e]); w0[e] = w1[e]; w1[e] = w2[e]; w2[e] = x3[e]; }
            u32x3 o; o.x = pk2(y[0], y[1]); o.y = pk2(y[2], y[3]); o.z = pk2(y[4], y[5]);
            *(u32x3*)(rowp0 + (size_t)(r4 + k) * 3072) = o;
        }
#pragma unroll
        for (int k = 0; k < 8; ++k) { cur[k] = n1[k]; n1[k] = n2[k]; }
    }
}
__device__ __forceinline__ void conv_prepass(const Params& p, unsigned* barword, const int G) {
    const int tid = threadIdx.x, bid = blockIdx.x;
    bf16_t* XBC = (bf16_t*)(p.ws + W_XBC);
    const int ch0 = tid * 6;
    u32x3 h0 = {0u, 0u, 0u}, h1 = h0, h2 = h0;
    if (bid < 256) {
        const int b = bid & 7, blk = bid >> 3; const size_t rbase = (size_t)b * 8192 + (size_t)blk * 256;
        if (blk > 0) { h0 = *(const u32x3*)(XBC + (rbase - 3) * 3072 + ch0); h1 = *(const u32x3*)(XBC + (rbase - 2) * 3072 + ch0); h2 = *(const u32x3*)(XBC + (rbase - 1) * 3072 + ch0); }
    }
    grid_bar(barword, (unsigned)G);
    float cwt[4][6], cb[6];
#pragma unroll
    for (int t = 0; t < 4; ++t)
#pragma unroll
        for (int e = 0; e < 6; e += 2) { const float2 a = *(const float2*)(p.conv_w + t * 3072 + ch0 + e); cwt[t][e] = a.x; cwt[t][e + 1] = a.y; }
#pragma unroll
    for (int e = 0; e < 6; e += 2) { const float2 a = *(const float2*)(p.conv_b + ch0 + e); cb[e] = a.x; cb[e + 1] = a.y; }
    if (bid < 256) {
        const int b = bid & 7, blk = bid >> 3; const size_t rbase = (size_t)b * 8192 + (size_t)blk * 256;
        float w0[6], w1[6], w2[6]; unpack6(h0, w0); unpack6(h1, w1); unpack6(h2, w2);
        conv_rows(XBC + rbase * 3072 + ch0, 256, w0, w1, w2, cwt, cb, blk == 31 ? p.out + O_CP + (size_t)b * 3 * 3072 + ch0 : nullptr);
    }
    if (bid < 16) {
        const int sb = bid; const float* sc = p.state_conv + (size_t)sb * 3 * 3072 + ch0;
        float w0[6], w1[6], w2[6];
#pragma unroll
        for (int e = 0; e < 6; ++e) { w0[e] = sc[e]; w1[e] = sc[3072 + e]; w2[e] = sc[2 * 3072 + e]; }
        conv_rows(XBC + ((size_t)TP + sb * 32) * 3072 + ch0, 32, w0, w1, w2, cwt, cb, p.out + O_CS + (size_t)sb * 3 * 3072 + ch0);
    }
}

constexpr int CS_OFF = 0, BS_OFF = 17408, BT_OFF = 34816, XT_OFF = 53248, MS_OFF = 62464, HS_OFF = 71680, YS_OFF = 89088, SC_OFF = 106496;
constexpr int ST136 = 136, ST72 = 72, YS_ST = 68;

__device__ __forceinline__ void ssd_seq(const Params& p, unsigned char* lds, const int is_sample, const int b, const int h) {
    const int tid = threadIdx.x, lane = tid & 63, wave = tid >> 6, fr = lane & 15, fq = lane >> 4;
    const int g = h >> 3;
    const bf16_t* XBC = (const bf16_t*)(p.ws + W_XBC); bf16_t* Z = (bf16_t*)(p.ws + W_Z); const float* DT = (const float*)(p.ws + W_DT); float* SSQG = (float*)(p.ws + W_SSQG);
    bf16_t* Cs = (bf16_t*)(lds + CS_OFF); bf16_t* Bs = (bf16_t*)(lds + BS_OFF); bf16_t* Bt = (bf16_t*)(lds + BT_OFF); bf16_t* Xt = (bf16_t*)(lds + XT_OFF);
    bf16_t* Ms = (bf16_t*)(lds + MS_OFF); bf16_t* Hs = (bf16_t*)(lds + HS_OFF); float* Ys = (float*)(lds + YS_OFF);
    float* dt_s = (float*)(lds + SC_OFF); float* cum_s = dt_s + 64; float* ecum_s = dt_s + 128; float* toend_s = dt_s + 192;
    const int nchunks = is_sample ? 1 : 128, Lc = is_sample ? 32 : 64;
    const size_t tseq0 = is_sample ? (size_t)TP + b * 32 : (size_t)b * 8192;
    const float a_h = -__expf(p.a_log[h]); const float d_h = p.d_skip[h];
    const int xrow = tid >> 3, xcg = tid & 7;
    const int brow = tid >> 4, bcg = tid & 15;
    const int erow = tid >> 3, epg = tid & 7;
    const int pt = wave & 3, nt0 = (wave >> 2) * 4, it = wave >> 1;
    f32x4 Hacc[4];
#pragma unroll
    for (int k = 0; k < 4; ++k)
#pragma unroll
        for (int r = 0; r < 4; ++r) Hacc[k][r] = is_sample ? p.state_ssm[((size_t)(b * 32 + h) * 64 + pt * 16 + fq * 4 + r) * 128 + (nt0 + k) * 16 + fr] : 0.f;
    u32x4 rx = {0u, 0u, 0u, 0u}, rb0 = rx, rb1 = rx, rc0 = rx, rc1 = rx, rz = rx; float rdt = 0.f;
#define SSD_LOAD_CHUNK(c) do { const size_t t0c_ = tseq0 + (size_t)(c) * 64; \
        if (xrow < Lc) rx = *(const u32x4*)(XBC + (t0c_ + xrow) * 3072 + h * 64 + xcg * 8); \
        { const bf16_t* rp_ = XBC + (t0c_ + brow) * 3072 + 2048 + g * 128 + bcg * 8; rb0 = *(const u32x4*)rp_; rc0 = *(const u32x4*)(rp_ + 512); \
          if (Lc == 64) { rb1 = *(const u32x4*)(rp_ + (size_t)32 * 3072); rc1 = *(const u32x4*)(rp_ + (size_t)32 * 3072 + 512); } } \
        if (wave == 0) rdt = lane < Lc ? DT[(t0c_ + lane) * 32 + h] : 0.f; } while (0)
#define SSD_EPILOGUE(c) do { const size_t t0e_ = tseq0 + (size_t)(c) * 64; \
        if (erow < Lc) { const float4 y0 = *(const float4*)(Ys + erow * YS_ST + epg * 8), y1 = *(const float4*)(Ys + erow * YS_ST + epg * 8 + 4); \
            float z_[8]; unpack8(rz, z_); float v_[8] = {y0.x, y0.y, y0.z, y0.w, y1.x, y1.y, y1.z, y1.w}; float ss_ = 0.f; \
            _Pragma("unroll") for (int e = 0; e < 8; ++e) { v_[e] *= siluf_(z_[e]); ss_ += v_[e] * v_[e]; } \
            *(u32x4*)(Z + (t0e_ + erow) * 2048 + h * 64 + epg * 8) = pack8(v_); \
            ss_ += __shfl_xor(ss_, 1); ss_ += __shfl_xor(ss_, 2); ss_ += __shfl_xor(ss_, 4); \
            if (epg == 0) SSQG[(t0e_ + erow) * 32 + h] = ss_; } } while (0)
#define SSD_T16(dst, w, e) dst = (bf16_t)((e) & 1 ? ((w) >> 16) : ((w) & 0xffffu))
    SSD_LOAD_CHUNK(0);
    for (int c = 0; c < nchunks; ++c) {
        __syncthreads();
        if (c > 0) SSD_EPILOGUE(c - 1);
        { const unsigned xw[4] = {rx.x, rx.y, rx.z, rx.w}, b0w[4] = {rb0.x, rb0.y, rb0.z, rb0.w}, b1w[4] = {rb1.x, rb1.y, rb1.z, rb1.w};
          const int xpos = (((xrow >> 3) ^ xcg) << 3) + (xrow & 7), bpos0 = (((brow >> 3) ^ (bcg & 7)) << 3) + (brow & 7), bpos1 = ((((brow + 32) >> 3) ^ (bcg & 7)) << 3) + (brow & 7);
#pragma unroll
          for (int e = 0; e < 8; ++e) { SSD_T16(Xt[(xcg * 8 + e) * ST72 + xpos], xw[e >> 1], e); SSD_T16(Bt[(bcg * 8 + e) * ST72 + bpos0], b0w[e >> 1], e); SSD_T16(Bt[(bcg * 8 + e) * ST72 + bpos1], b1w[e >> 1], e); }
          *(u32x4*)(Bs + brow * ST136 + bcg * 8) = rb0; *(u32x4*)(Bs + (brow + 32) * ST136 + bcg * 8) = rb1;
          *(u32x4*)(Cs + brow * ST136 + bcg * 8) = rc0; *(u32x4*)(Cs + (brow + 32) * ST136 + bcg * 8) = rc1; }
        if (wave == 0) {
            float x = rdt * a_h;
#pragma unroll
            for (int off = 1; off < 64; off <<= 1) { const float y = __shfl_up(x, off); if (lane >= off) x += y; }
            const float cl = __shfl(x, 63);
            dt_s[lane] = rdt; cum_s[lane] = x; ecum_s[lane] = __expf(x); toend_s[lane] = __expf(cl - x) * rdt;
        }
#pragma unroll
        for (int k = 0; k < 4; ++k)
#pragma unroll
            for (int r = 0; r < 4; ++r) Hs[(pt * 16 + fq * 4 + r) * ST136 + (nt0 + k) * 16 + fr] = f2bf(Hacc[k][r]);
        if (erow < Lc) rz = *(const u32x4*)(Z + (tseq0 + (size_t)c * 64 + erow) * 2048 + h * 64 + epg * 8);
        if (c + 1 < nchunks) SSD_LOAD_CHUNK(c + 1);
        __syncthreads();
#pragma unroll
        for (int jj = 0; jj < 2; ++jj) {
            const int jt = (wave & 1) * 2 + jj;
            f32x4 acc = {0.f, 0.f, 0.f, 0.f};
            if (jt <= it) {
#pragma unroll
                for (int ks = 0; ks < 4; ++ks) acc = __builtin_amdgcn_mfma_f32_16x16x32_bf16(*(const bf16x8*)(Cs + (it * 16 + fr) * ST136 + ks * 32 + fq * 8), *(const bf16x8*)(Bs + (jt * 16 + fr) * ST136 + ks * 32 + fq * 8), acc, 0, 0, 0);
            }
            const int j = jt * 16 + fr; const float cj = cum_s[j], dj = dt_s[j];
#pragma unroll
            for (int r = 0; r < 4; ++r) { const int i = it * 16 + fq * 4 + r;
                float val = (jt <= it && j <= i) ? acc[r] * __expf(cum_s[i] - cj) * dj : 0.f;
                if (i == j) val += d_h;
                Ms[i * ST72 + j] = f2bf(val); }
        }
        f32x4 accY[2];
#pragma unroll
        for (int pp = 0; pp < 2; ++pp) { const int ptile = (wave & 1) * 2 + pp; accY[pp] = (f32x4){0.f, 0.f, 0.f, 0.f};
#pragma unroll
            for (int ks = 0; ks < 4; ++ks) accY[pp] = __builtin_amdgcn_mfma_f32_16x16x32_bf16(*(const bf16x8*)(Cs + (it * 16 + fr) * ST136 + ks * 32 + fq * 8), *(const bf16x8*)(Hs + (ptile * 16 + fr) * ST136 + ks * 32 + fq * 8), accY[pp], 0, 0, 0);
#pragma unroll
            for (int r = 0; r < 4; ++r) accY[pp][r] *= ecum_s[it * 16 + fq * 4 + r]; }
        __syncthreads();
#pragma unroll
        for (int pp = 0; pp < 2; ++pp) { const int ptile = (wave & 1) * 2 + pp;
#pragma unroll
            for (int ks = 0; ks < 2; ++ks) if (ks * 32 <= it * 16 + 15)
                accY[pp] = __builtin_amdgcn_mfma_f32_16x16x32_bf16(*(const bf16x8*)(Ms + (it * 16 + fr) * ST72 + ks * 32 + fq * 8), *(const bf16x8*)(Xt + (ptile * 16 + fr) * ST72 + (((ks * 4 + fq) ^ ((ptile * 2 + (fr >> 3)) & 7)) << 3)), accY[pp], 0, 0, 0);
#pragma unroll
            for (int r = 0; r < 4; ++r) Ys[(it * 16 + fq * 4 + r) * YS_ST + ptile * 16 + fr] = accY[pp][r]; }
        { const float dec = ecum_s[63];
          bf16x8 xa[2];
#pragma unroll
          for (int ks = 0; ks < 2; ++ks) { float xv[8]; unpack8(*(const u32x4*)(Xt + (pt * 16 + fr) * ST72 + (((ks * 4 + fq) ^ ((pt * 2 + (fr >> 3)) & 7)) << 3)), xv);
              const float4 t0 = *(const float4*)(toend_s + ks * 32 + fq * 8), t1 = *(const float4*)(toend_s + ks * 32 + fq * 8 + 4);
              xv[0] *= t0.x; xv[1] *= t0.y; xv[2] *= t0.z; xv[3] *= t0.w; xv[4] *= t1.x; xv[5] *= t1.y; xv[6] *= t1.z; xv[7] *= t1.w;
              union { u32x4 u; bf16x8 v; } cvt; cvt.u = pack8(xv); xa[ks] = cvt.v; }
#pragma unroll
          for (int k = 0; k < 4; ++k) {
#pragma unroll
              for (int r = 0; r < 4; ++r) Hacc[k][r] *= dec;
#pragma unroll
              for (int ks = 0; ks < 2; ++ks) Hacc[k] = __builtin_amdgcn_mfma_f32_16x16x32_bf16(xa[ks], *(const bf16x8*)(Bt + ((nt0 + k) * 16 + fr) * ST72 + (((ks * 4 + fq) ^ (((nt0 + k) * 2 + (fr >> 3)) & 7)) << 3)), Hacc[k], 0, 0, 0); } }
    }
    __syncthreads();
    SSD_EPILOGUE(nchunks - 1);
#undef SSD_LOAD_CHUNK
#undef SSD_EPILOGUE
#undef SSD_T16
    float* hs = p.out + (is_sample ? O_SS : O_SP) + (size_t)(b * 32 + h) * 64 * 128;
#pragma unroll
    for (int k = 0; k < 4; ++k)
#pragma unroll
        for (int r = 0; r < 4; ++r) hs[(pt * 16 + fq * 4 + r) * 128 + (nt0 + k) * 16 + fr] = Hacc[k][r];
}

struct TileOrder {
    int ntiles, nwg, c;
    __device__ __forceinline__ bool next(int i, pg8::Unit& u) const { const int L = i * nwg + c; if (L >= ntiles) return false; const int q = L & 7, r = L >> 3; u.pn = r & 3; u.pm = ((r >> 2) << 3) + q; return true; }
    __device__ __forceinline__ void a_ready(const pg8::Unit&) const {}
    __device__ __forceinline__ void done(const pg8::Unit&) const {}
};
struct SampleOrder {
    int c;
    __device__ __forceinline__ bool next(int i, pg8::Unit& u) const { if (i > 0) return false; u.pm = 256 + (c >> 2); u.pn = c & 3; return true; }
    __device__ __forceinline__ void a_ready(const pg8::Unit&) const {}
    __device__ __forceinline__ void done(const pg8::Unit&) const {}
};
typedef EpiOutT<0> EpiOut;
__device__ __forceinline__ void post_rows(const Params& p, int t0, const int t1, const int tstride, const int lane) {
    const float* SSQO = (const float*)(p.ws + W_SSQO);
    float4 w[4];
#pragma unroll
    for (int i = 0; i < 4; ++i) w[i] = *(const float4*)(p.post_norm_w + i * 256 + lane * 4);
    float4 xv[2][4], nx[2][4]; u32x2 ov[2][4], no[2][4]; float sp[2], ns[2];
#define PR_LOAD(XV, OV, SP, tb_) do { _Pragma("unroll") for (int k = 0; k < 2; ++k) { const int t_ = (tb_) + k * tstride; const int tt_ = t_ < t1 ? t_ : t0; \
        const float* xr_ = tt_ < TP ? p.x_prompt + (size_t)tt_ * DM : p.x_sample + (size_t)(tt_ - TP) * DM; const bf16_t* or_ = (const bf16_t*)(p.ws + W_Z) + (size_t)tt_ * DM; \
        SP[k] = lane < 16 ? SSQO[(size_t)tt_ * 16 + lane] : 0.f; \
        _Pragma("unroll") for (int i = 0; i < 4; ++i) { XV[k][i] = *(const float4*)(xr_ + i * 256 + lane * 4); OV[k][i] = *(const u32x2*)(or_ + i * 256 + lane * 4); } } } while (0)
    int tb = t0;
    if (tb < t1) PR_LOAD(xv, ov, sp, tb);
    for (; tb < t1; tb += 2 * tstride) {
        if (tb + 2 * tstride < t1) PR_LOAD(nx, no, ns, tb + 2 * tstride);
#pragma unroll
        for (int k = 0; k < 2; ++k) { const int t = tb + k * tstride; if (t < t1) {
            float s = sp[k]; s += __shfl_xor(s, 1); s += __shfl_xor(s, 2); s += __shfl_xor(s, 4); s += __shfl_xor(s, 8); s = __shfl(s, 0);
            const float r = rsqrtf(s * (1.0f / 1024.0f) + 1e-6f); float* yr = p.out + (size_t)t * DM;
#pragma unroll
            for (int i = 0; i < 4; ++i) { const float4 x = xv[k][i]; const u32x2 ow = ov[k][i]; const float4 o = make_float4(__uint_as_float(ow.x << 16), __uint_as_float(ow.x & 0xffff0000u), __uint_as_float(ow.y << 16), __uint_as_float(ow.y & 0xffff0000u));
                *(float4*)(yr + i * 256 + lane * 4) = make_float4(x.x + o.x * r * w[i].x, x.y + o.y * r * w[i].y, x.z + o.z * r * w[i].z, x.w + o.w * r * w[i].w); } } }
#pragma unroll
        for (int k = 0; k < 2; ++k) { sp[k] = ns[k];
#pragma unroll
            for (int i = 0; i < 4; ++i) { xv[k][i] = nx[k][i]; ov[k][i] = no[k][i]; } }
    }
#undef PR_LOAD
}

__device__ __forceinline__ void grid_bar(unsigned* word, unsigned G) {
    asm volatile("s_waitcnt vmcnt(0) lgkmcnt(0)" ::: "memory");
    __syncthreads();
    if (threadIdx.x == 0) {
        __builtin_amdgcn_fence(__ATOMIC_RELEASE, "agent");
        asm volatile("s_waitcnt vmcnt(0)" ::: "memory");
        __hip_atomic_fetch_add(word, 1u, __ATOMIC_RELAXED, __HIP_MEMORY_SCOPE_AGENT);
        while (__hip_atomic_load(word, __ATOMIC_RELAXED, __HIP_MEMORY_SCOPE_AGENT) < G) __builtin_amdgcn_s_sleep(4);
        __builtin_amdgcn_fence(__ATOMIC_ACQUIRE, "agent");
        asm volatile("s_waitcnt vmcnt(0)" ::: "memory");
    }
    __syncthreads();
}

__global__ void __launch_bounds__(NTHR, 2) mega_fwd(Params p) {
    extern __shared__ __attribute__((aligned(16))) unsigned char lds[];
    cg::grid_group grid = cg::this_grid();
    const int tid = threadIdx.x, lane = tid & 63, wave = tid >> 6;
    const int G = gridDim.x, bid = blockIdx.x;
    const int lo = p.ph_lo, hi = p.ph_hi;
#define IN(k) (lo <= (k) && (k) < hi)
#define SEAM(k) do { if (IN(k) && IN((k) + 1)) grid_bar((unsigned*)(p.ws + W_BAR) + 32 * (k), (unsigned)G); } while (0)
    grid.sync();
    PG8_LAS unsigned char* glds = (PG8_LAS unsigned char*)lds;
    const bf16_t* Hn = (const bf16_t*)p.out;
    if (IN(0)) p0_prologue(p, lds);
    SEAM(0);
    if (IN(1)) { __syncthreads();
        pg8::Gemm g{Hn, (const bf16_t*)(p.ws + W_WIN), TT, NIN, 1024}; pg8::StaticOrder S; S.init(TT, NIN, G, bid);
        EpiInProj E{p.ws, p.dt_bias}; pg8::gemm_phase<EpiInProj, pg8::StaticOrder>(glds, g, S, E, nullptr); }
    SEAM(1);
    if (IN(2)) conv_prepass(p, (unsigned*)(p.ws + W_BAR) + 16, G);
    SEAM(2);
    if (IN(3)) {
        const int x = bid & 7, kq = bid >> 3;
        const bool std_grid = (G == 256);
        if (std_grid) {
#pragma unroll 1
            for (int k = 0; k < 3; ++k) { const int is_s = k > 0 ? 1 : 0, su = bid * 2 + (k - 1); ssd_seq(p, lds, is_s, is_s ? su >> 5 : x, is_s ? su & 31 : kq); }
            attn_run(p, lds, x, kq & 3, (kq >> 2) * 16);
            if (bid < 64) attn_unit(p, lds, 1, bid >> 2, 0, bid & 3);
        }
    }
    SEAM(3);
    if (IN(4)) {
        bf16_t* Z = (bf16_t*)(p.ws + W_Z); const float* SSQG = (const float*)(p.ws + W_SSQG);
        const size_t nit = (size_t)TT * 256, gs = (size_t)G * NTHR;
        for (size_t i0 = (size_t)bid * NTHR + tid; i0 < nit; i0 += 4 * gs) {
            u32x4 zv[4]; f32x4 s0[4], s1[4];
#pragma unroll
            for (int k = 0; k < 4; ++k) { const size_t i = i0 + k * gs; const size_t ii = i < nit ? i : i0; const size_t t = ii >> 8; const int c8 = (int)(ii & 255);
                s0[k] = *(const f32x4*)(SSQG + t * 32 + (c8 >> 6) * 8); s1[k] = *(const f32x4*)(SSQG + t * 32 + (c8 >> 6) * 8 + 4); zv[k] = *(const u32x4*)(Z + t * 2048 + c8 * 8); }
#pragma unroll
            for (int k = 0; k < 4; ++k) { const size_t i = i0 + k * gs; if (i < nit) { const size_t t = i >> 8; const int c8 = (int)(i & 255);
                const float r = rsqrtf((((s0[k][0] + s0[k][1]) + (s0[k][2] + s0[k][3])) + ((s1[k][0] + s1[k][1]) + (s1[k][2] + s1[k][3]))) * (1.0f / 512.0f) + 1e-6f);
                float v[8]; unpack8(zv[k], v);
#pragma unroll
                for (int e = 0; e < 8; ++e) v[e] *= r;
                *(u32x4*)(Z + t * 2048 + c8 * 8) = pack8(v); } }
        }
    }
    SEAM(4);
    bf16_t* GA = (bf16_t*)(p.ws + W_GA); bf16_t* GS = (bf16_t*)(p.ws + W_GS); bf16_t* MG = (bf16_t*)(p.ws + W_MG);
#define MERGE_CHAIN(SCHED, S) do { \
        { pg8::Gemm g{Hn, (const bf16_t*)(p.ws + W_WG), TT, 1024, 1024}; EpiMerge<0> E{GA, nullptr}; pg8::gemm_phase<EpiMerge<0>, SCHED>(glds, g, S, E, nullptr); } \
        { pg8::Gemm g{Hn, (const bf16_t*)(p.ws + W_WG) + (size_t)1024 * 1024, TT, 1024, 1024}; EpiMerge<0> E{GS, nullptr}; pg8::gemm_phase<EpiMerge<0>, SCHED>(glds, g, S, E, nullptr); } \
        { pg8::Gemm g{(const bf16_t*)(p.ws + W_Q), (const bf16_t*)(p.ws + W_WAO), TT, 1024, 1024}; EpiMerge<1> E{MG, GA}; pg8::gemm_phase<EpiMerge<1>, SCHED>(glds, g, S, E, nullptr); } \
        { pg8::Gemm g{(const bf16_t*)(p.ws + W_Z), (const bf16_t*)(p.ws + W_WSO), TT, 1024, 2048}; EpiMerge<2> E{MG, GS}; pg8::gemm_phase<EpiMerge<2>, SCHED>(glds, g, S, E, nullptr); } } while (0)
#define OUT_GEMM(SCHED, S) do { pg8::Gemm g{(const bf16_t*)(p.ws + W_MG), (const bf16_t*)(p.ws + W_WOUT), TT, 1024, 1024}; \
        EpiOut E{(bf16_t*)(p.ws + W_Z), (float*)(p.ws + W_SSQO)}; pg8::gemm_phase<EpiOut, SCHED>(glds, g, S, E, nullptr); } while (0)
    if (IN(5)) { __syncthreads(); const TileOrder S{1024, G, bid}; MERGE_CHAIN(TileOrder, S); }
    SEAM(5);
    if (IN(6)) { __syncthreads();
        if (bid < 8) { const SampleOrder S{bid};
            { pg8::Gemm g{Hn, (const bf16_t*)(p.ws + W_WG), TT, 1024, 1024}; EpiMerge<0> E{GA, nullptr}; pg8::gemm_phase<EpiMerge<0>, SampleOrder>(glds, g, S, E, nullptr); }
            { pg8::Gemm g{(const bf16_t*)(p.ws + W_Q), (const bf16_t*)(p.ws + W_WAO), TT, 1024, 1024}; EpiMerge<1> E{MG, GA}; pg8::gemm_phase<EpiMerge<1>, SampleOrder>(glds, g, S, E, nullptr); } }
        else if (bid < 16) { const SampleOrder S{bid - 8};
            { pg8::Gemm g{Hn, (const bf16_t*)(p.ws + W_WG) + (size_t)1024 * 1024, TT, 1024, 1024}; EpiMerge<0> E{GS, nullptr}; pg8::gemm_phase<EpiMerge<0>, SampleOrder>(glds, g, S, E, nullptr); }
            { pg8::Gemm g{(const bf16_t*)(p.ws + W_Z), (const bf16_t*)(p.ws + W_WSO), TT, 1024, 2048}; EpiMerge<1> E{GS, GS}; pg8::gemm_phase<EpiMerge<1>, SampleOrder>(glds, g, S, E, nullptr); } }
        else { const TileOrder S{1024, G - 16, bid - 16}; OUT_GEMM(TileOrder, S); } }
    SEAM(6);
    if (IN(7)) {
        if (bid < 8) { __syncthreads(); const SampleOrder S{bid}; OUT_GEMM(SampleOrder, S);
            { pg8::Gemm g{(const bf16_t*)(p.ws + W_GS), (const bf16_t*)(p.ws + W_WOUT), TT, 1024, 1024}; EpiOutT<1> E{(bf16_t*)(p.ws + W_Z), (float*)(p.ws + W_SSQO)}; pg8::gemm_phase<EpiOutT<1>, SampleOrder>(glds, g, S, E, nullptr); } }
        else post_rows(p, (bid - 8) * 8 + wave, TP, (G - 8) * 8, lane); }
    if (IN(7) && bid < 8) { grid_bar((unsigned*)(p.ws + W_BAR) + 20, 8u); post_rows(p, TP + bid * 8 + wave, TT, 8 * 8, lane); }
#undef IN
#undef SEAM
}

extern "C" void kernel_launch(void* const* d_in, const int* in_sizes, int n_in, void* d_out, int out_size, void* d_ws, size_t ws_size, hipStream_t stream) {
    static int grid = 0;
    if (grid == 0) {
        int dev = 0, cus = 0, per_cu = 0;
        (void)hipGetDevice(&dev); (void)hipDeviceGetAttribute(&cus, hipDeviceAttributeMultiprocessorCount, dev);
        (void)hipFuncSetAttribute((const void*)mega_fwd, hipFuncAttributeMaxDynamicSharedMemorySize, LDS_BYTES);
        (void)hipOccupancyMaxActiveBlocksPerMultiprocessor(&per_cu, (const void*)mega_fwd, NTHR, LDS_BYTES);
        if (per_cu < 1) { fprintf(stderr, "kernel_launch: occupancy query says %d blocks per CU\n", per_cu); per_cu = 1; }
        (void)hipGetLastError();
        grid = cus > 0 ? cus : 256;
        if (ws_size < W_END) fprintf(stderr, "kernel_launch: workspace too small: %zu < %zu\n", ws_size, (size_t)W_END);
    }
    Params p{};
    const float** pp = (const float**)&p;
    for (int i = 0; i < 19; ++i) pp[i] = (const float*)d_in[i];
    p.out = (float*)d_out; p.ws = (unsigned char*)d_ws; p.ph_lo = 0; p.ph_hi = 9; p.dbg = 0; p.ws_size = (unsigned long long)ws_size;
    (void)hipMemsetAsync((unsigned char*)d_ws + W_BAR, 0, 1024, stream);
    void* args[] = {&p};
    hipError_t e = hipLaunchCooperativeKernel((const void*)mega_fwd, dim3(grid), dim3(NTHR), args, LDS_BYTES, stream);
    if (e != hipSuccess) fprintf(stderr, "cooperative launch failed: %s (grid %d)\n", hipGetErrorString(e), grid);
}
```

```cpp
#include <hip/hip_runtime.h>
#include <hip/hip_cooperative_groups.h>
#include <cstdio>
namespace pg8 {
#define PG8_LAS __attribute__((address_space(3)))
typedef unsigned short bf16_t;
typedef short bf16x8 __attribute__((ext_vector_type(8)));
typedef float f32x4 __attribute__((ext_vector_type(4)));
typedef unsigned u32x4 __attribute__((ext_vector_type(4)));
constexpr int BM = 256, BK = 64, HALF = 128, HTB = HALF * BK * 2  , STAGE_BYTES = 8 * HTB, NXCD = 8, WGM = 8;

__host__ __device__ __forceinline__ int lds_byte(int r, int c) { const int st = (r >> 4) * 2 + (c >> 5), rr = r & 15, cc = c & 31, ob = rr * 64 + cc * 2; return st * 1024 + (ob ^ (((ob >> 9) & 1) << 5)); }
__host__ __device__ __forceinline__ void stage_rc(int b, int& R, int& C) { const int st = b / 1024, sb = b % 1024, swz = sb ^ (((sb >> 9) & 1) << 5); R = (st >> 1) * 16 + swz / 64; C = (st & 1) * 32 + (swz % 64) / 2; }
__host__ __device__ __forceinline__ int perm32(int rho) { const int n = rho >> 4, i = rho & 15; return 8 * (i >> 2) + 4 * n + (i & 3); }

struct Unit { int pm, pn; };
struct Gemm { const bf16_t* A; const bf16_t* Bt; int M, N, K; };

struct StaticOrder {
    int nM, nN, nwg, G, c;
    __host__ __device__ void init(int M, int N, int G_, int c_) { nM = M / BM; nN = N / BM; nwg = nM * nN; G = G_; c = c_; }
    __host__ __device__ bool next(int i, Unit& u) const {
        const long L = (long)i * G + c; if (L >= nwg) return false;
        int wgid = (int)L; { const int q = nwg / NXCD, r = nwg % NXCD, xcd = wgid % NXCD, off = wgid / NXCD; wgid = (xcd < r ? xcd * (q + 1) : r * (q + 1) + (xcd - r) * q) + off; }
        const int nig = WGM * nN, gid = wgid / nig, fm = gid * WGM, gsz = (nM - fm) < WGM ? (nM - fm) : WGM;
        u.pm = fm + ((wgid % nig) % gsz); u.pn = (wgid % nig) / gsz; return true;
    }
    __device__ __forceinline__ void a_ready(const Unit&) const {}
    __device__ __forceinline__ void done(const Unit&) const {}
};
__device__ __forceinline__ unsigned cvt_pk_bf16(float lo, float hi) { unsigned r; asm volatile("s_nop 0\n\tv_cvt_pk_bf16_f32 %0, %1, %2" : "=v"(r) : "v"(lo), "v"(hi)); return r; }
typedef float f32x2 __attribute__((ext_vector_type(2)));
template <class Epi, class Sched, bool STAMP = false>
__device__ __forceinline__ void gemm_phase(PG8_LAS unsigned char* lds, const Gemm g, const Sched& S, const Epi& E, unsigned long long* stamps) {
    const int tid = threadIdx.x, wid = __builtin_amdgcn_readfirstlane(tid >> 6), lane = tid & 63, wr = wid >> 2, wc = wid & 3, fr = lane & 15, fq = lane >> 4;
    const int K = g.K, nt = K / BK;
    int ts_lo = 0, ts_hi = 0, nts = 0; const unsigned long long rt_entry = STAMP ? (unsigned long long)wall_clock64() : 0ull;
#define PG8_STAMP() do { if (STAMP && wid == 0 && nts < 64) { const unsigned long long _c = (unsigned long long)clock64(); \
        ts_lo = (lane == nts) ? (int)(unsigned)_c : ts_lo; ts_hi = (lane == nts) ? (int)(unsigned)(_c >> 32) : ts_hi; ++nts; } } while (0)
    PG8_STAMP();
    unsigned voffA[2], voffB[2];
#pragma unroll
    for (int i = 0; i < 2; ++i) { int R, C; stage_rc(tid * 16 + i * 8192, R, C); const int Rb = Epi::PERM ? ((R & ~31) + perm32(R & 31)) : R;
        voffA[i] = (unsigned)(R * K + C) * 2u; voffB[i] = (unsigned)(Rb * K + C) * 2u; }
    const size_t kstep = (size_t)(BK * 2);
    const size_t hstep = (size_t)HALF * K * 2;
    const size_t tstep = 2 * hstep;
    const unsigned ldsw = (unsigned)wid * 1024u;
    const int aoff = lds_byte(wr * 64 + fr, fq * 8), boff = lds_byte(wc * 32 + fr, fq * 8);
#define PG8_SA(b, h) (((b) * 2 + (h)) * HTB)
#define PG8_SB(b, h) ((4 + (b) * 2 + (h)) * HTB)
#define PG8_STAGE(bufoff, gbase, voff) do { _Pragma("unroll") for (int _i = 0; _i < 2; ++_i) \
        __builtin_amdgcn_global_load_lds((const unsigned*)((const char*)(gbase) + (voff)[_i]), (PG8_LAS unsigned*)(lds + (bufoff) + ldsw + _i * 8192), 16, 0, 0); } while (0)
#define PG8_LDA(dst, b, h) do { _Pragma("unroll") for (int m = 0; m < 4; ++m) _Pragma("unroll") for (int k = 0; k < 2; ++k) dst[m][k] = *(const PG8_LAS bf16x8*)(lds + PG8_SA(b, h) + aoff + m * 2048 + k * 1024); } while (0)
#define PG8_LDB(dst, b, h) do { _Pragma("unroll") for (int n = 0; n < 2; ++n) _Pragma("unroll") for (int k = 0; k < 2; ++k) dst[n][k] = *(const PG8_LAS bf16x8*)(lds + PG8_SB(b, h) + boff + n * 2048 + k * 1024); } while (0)
#define PG8_MMA(ai, bj, At, Bt) do { __builtin_amdgcn_s_setprio(1); _Pragma("unroll") for (int m = 0; m < 4; ++m) _Pragma("unroll") for (int n = 0; n < 2; ++n) _Pragma("unroll") for (int k = 0; k < 2; ++k) \
        acc[ai][bj][m][n] = __builtin_amdgcn_mfma_f32_16x16x32_bf16(Bt[n][k], At[m][k], acc[ai][bj][m][n], 0, 0, 0); __builtin_amdgcn_s_setprio(0); } while (0)
#define PG8_WAIT_V(n) asm volatile("s_waitcnt vmcnt(" #n ")" ::: "memory")
#define PG8_WAIT_L(n) asm volatile("s_waitcnt lgkmcnt(" #n ")" ::: "memory")
#define PG8_BAR __builtin_amdgcn_s_barrier()
#define PG8_SCHED __builtin_amdgcn_sched_barrier(0)
    Unit cur, nxt; int ui = 0;
    if (!S.next(0, cur)) return;
    f32x4 acc[2][2][4][2];
#pragma unroll
    for (int a = 0; a < 2; ++a)
#pragma unroll
        for (int b = 0; b < 2; ++b)
#pragma unroll
            for (int m = 0; m < 4; ++m)
#pragma unroll
                for (int n = 0; n < 2; ++n) acc[a][b][m][n] = (f32x4){0.f, 0.f, 0.f, 0.f};
    bf16x8 At[4][2], B0[2][2], B1[2][2];
    const char* cA = (const char*)g.A + (size_t)cur.pm * tstep; const char* cB = (const char*)g.Bt + (size_t)cur.pn * tstep;
    S.a_ready(cur);
    PG8_STAGE(PG8_SB(0, 0), cB, voffB); PG8_STAGE(PG8_SA(0, 0), cA, voffA); PG8_STAGE(PG8_SB(0, 1), cB + hstep, voffB); PG8_STAGE(PG8_SA(0, 1), cA + hstep, voffA);
    if (wr == 1) PG8_BAR;
    PG8_WAIT_V(4); PG8_BAR;
    PG8_STAGE(PG8_SB(1, 0), cB + kstep, voffB); PG8_STAGE(PG8_SA(1, 0), cA + kstep, voffA); PG8_STAGE(PG8_SB(1, 1), cB + hstep + kstep, voffB);
    PG8_WAIT_V(6); PG8_BAR;
    PG8_STAMP();
    for (;;) {
        const bool has_next = S.next(ui + 1, nxt);
        const char* nA = has_next ? (const char*)g.A + (size_t)nxt.pm * tstep : cA; const char* nB = has_next ? (const char*)g.Bt + (size_t)nxt.pn * tstep : cB;
        for (int t = 0; t < nt; t += 2) {
            const bool last = (t == nt - 2);
            const char* a1 = cA + (size_t)(t + 1) * kstep;
            const char* a2 = last ? nA : cA + (size_t)(t + 2) * kstep; const char* b2 = last ? nB : cB + (size_t)(t + 2) * kstep;
            const char* a3 = a2 + kstep; const char* b3 = b2 + kstep;
            if (last && has_next) S.a_ready(nxt);
            PG8_LDB(B0, 0, 0); PG8_SCHED; PG8_LDA(At, 0, 0); PG8_STAGE(PG8_SA(1, 1), a1 + hstep, voffA);
            PG8_WAIT_L(8); PG8_BAR; PG8_WAIT_L(0); PG8_MMA(0, 0, At, B0); PG8_BAR; PG8_SCHED;
            PG8_LDB(B1, 0, 1); PG8_STAGE(PG8_SB(0, 0), b2, voffB);
            PG8_BAR; PG8_WAIT_L(0); PG8_MMA(0, 1, At, B1); PG8_BAR;
            PG8_LDA(At, 0, 1); PG8_STAGE(PG8_SA(0, 0), a2, voffA);
            PG8_BAR; PG8_WAIT_L(0); PG8_MMA(1, 0, At, B0); PG8_BAR; PG8_SCHED;
            PG8_STAGE(PG8_SB(0, 1), b2 + hstep, voffB);
            PG8_WAIT_V(6); PG8_BAR; PG8_MMA(1, 1, At, B1); PG8_BAR;
            PG8_LDB(B0, 1, 0); PG8_SCHED; PG8_LDA(At, 1, 0); PG8_STAGE(PG8_SA(0, 1), a2 + hstep, voffA);
            PG8_WAIT_L(8); PG8_BAR; PG8_WAIT_L(0); PG8_MMA(0, 0, At, B0); PG8_BAR; PG8_SCHED;
            PG8_LDB(B1, 1, 1); PG8_STAGE(PG8_SB(1, 0), b3, voffB);
            PG8_BAR; PG8_WAIT_L(0); PG8_MMA(0, 1, At, B1); PG8_BAR;
            PG8_LDA(At, 1, 1); PG8_STAGE(PG8_SA(1, 0), a3, voffA);
            PG8_BAR; PG8_WAIT_L(0); PG8_MMA(1, 0, At, B0); PG8_BAR; PG8_SCHED;
            PG8_STAGE(PG8_SB(1, 1), b3 + hstep, voffB);
            PG8_WAIT_V(6); PG8_BAR; PG8_MMA(1, 1, At, B1); PG8_BAR;
        }
        PG8_STAMP();
        if constexpr (!Epi::AFTER_DRAIN) { E(acc, cur, wr, wc, fr, fq); S.done(cur); }
        PG8_STAMP();
        if (!has_next) break;
#pragma unroll
        for (int a = 0; a < 2; ++a)
#pragma unroll
            for (int b = 0; b < 2; ++b)
#pragma unroll
                for (int m = 0; m < 4; ++m)
#pragma unroll
                    for (int n = 0; n < 2; ++n) acc[a][b][m][n] = (f32x4){0.f, 0.f, 0.f, 0.f};
        cur = nxt; cA = nA; cB = nB; ++ui;
    }
    PG8_WAIT_V(0);
    if (wr == 0) PG8_BAR;
    PG8_BAR;
    if constexpr (Epi::AFTER_DRAIN) { E.fused(acc, cur, wr, wc, fr, fq, lds, wid, lane); S.done(cur); }
    PG8_STAMP();
    if (STAMP && wid == 0) { stamps[lane] = lane < nts ? (((unsigned long long)(unsigned)ts_hi << 32) | (unsigned)ts_lo) : 0ull;
        if (lane == 62) stamps[62] = rt_entry; if (lane == 63) stamps[63] = (unsigned long long)wall_clock64(); }
#undef PG8_STAMP
#undef PG8_SA
#undef PG8_SB
#undef PG8_STAGE
#undef PG8_LDA
#undef PG8_LDB
#undef PG8_MMA
#undef PG8_WAIT_V
#undef PG8_WAIT_L
#undef PG8_BAR
#undef PG8_SCHED
}
}

namespace cg = cooperative_groups;
typedef unsigned short bf16_t;
typedef short bf16x8 __attribute__((ext_vector_type(8)));
typedef short bf16x4 __attribute__((ext_vector_type(4)));
typedef float f32x4 __attribute__((ext_vector_type(4)));
typedef unsigned u32x4 __attribute__((ext_vector_type(4)));
typedef unsigned u32x2 __attribute__((ext_vector_type(2)));

constexpr int TP = 65536, TS = 512, TT = TP + TS;
constexpr int DM = 1024;
constexpr int NTHR = 512;
constexpr int LDS_BYTES = 131072;
constexpr int NIN = 7936;
constexpr int IN_W = 9760;

constexpr size_t O_YP = 0, O_YS = 67108864, O_KP = 67633152, O_VP = 67895296, O_CP = 68157440, O_SP = 68231168,
                 O_KS = 70328320, O_VS = 70459392, O_CS = 70590464, O_SS = 70737920;
constexpr size_t SZ1K = (size_t)TT * 1024 * 2;
constexpr size_t W_Q = 0, W_K = W_Q + SZ1K, W_V = W_K + SZ1K / 4, W_G = W_V + SZ1K / 4, W_Z = W_G + SZ1K, W_XBC = W_Z + 2 * SZ1K,
                 W_DT = W_XBC + 3 * SZ1K, W_WIN = W_DT + (size_t)TT * 32 * 4, W_WG = W_WIN + (size_t)NIN * 1024 * 2, W_WAO = W_WG + 2048 * 1024 * 2,
                 W_WSO = W_WAO + 1024 * 1024 * 2, W_WOUT = W_WSO + 1024 * 2048 * 2, W_ROPE = W_WOUT + 1024 * 1024 * 2,
                 W_SSQG = W_ROPE + 8224 * 8 * 8, W_SSQO = W_SSQG + (size_t)TT * 32 * 4, W_BAR = W_SSQO + (size_t)TT * 16 * 4, W_END = W_BAR + 1024;
constexpr size_t W_GA = W_XBC, W_GS = W_XBC + SZ1K, W_MG = W_XBC + 2 * SZ1K;
static_assert(W_END <= (size_t)1073741824, "workspace");

struct Params {
    const float *x_prompt, *x_sample, *cache_k, *cache_v, *state_conv, *state_ssm, *pre_norm_w, *w_in, *conv_w, *conv_b, *dt_bias, *a_log, *d_skip,
        *sinks, *ssm_norm_w, *w_attn_o, *w_ssm_o, *w_out, *post_norm_w;
    float* out; unsigned char* ws; int ph_lo, ph_hi; unsigned long long ws_size; int dbg, pad;
};

__device__ __forceinline__ unsigned short f2bf(float f) { unsigned u = __float_as_uint(f); u += 0x7FFFu + ((u >> 16) & 1u); return (unsigned short)(u >> 16); }
__device__ __forceinline__ float bf2f(unsigned short b) { return __uint_as_float(((unsigned)b) << 16); }
__device__ __forceinline__ float bf2f_s(short b) { return __uint_as_float(((unsigned)(unsigned short)b) << 16); }
__device__ __forceinline__ unsigned pk2(float lo, float hi) { return pg8::cvt_pk_bf16(lo, hi); }
__device__ __forceinline__ float sigmoidf_(float x) { return __builtin_amdgcn_rcpf(1.0f + __expf(-x)); }
__device__ __forceinline__ float siluf_(float x) { return x * __builtin_amdgcn_rcpf(1.0f + __expf(-x)); }
__device__ __forceinline__ void unpack8(const u32x4 w, float (&v)[8]) {
    v[0] = __uint_as_float(w.x << 16); v[1] = __uint_as_float(w.x & 0xffff0000u); v[2] = __uint_as_float(w.y << 16); v[3] = __uint_as_float(w.y & 0xffff0000u);
    v[4] = __uint_as_float(w.z << 16); v[5] = __uint_as_float(w.z & 0xffff0000u); v[6] = __uint_as_float(w.w << 16); v[7] = __uint_as_float(w.w & 0xffff0000u);
}
__device__ __forceinline__ u32x4 pack8(const float (&v)[8]) { u32x4 w; w.x = pk2(v[0], v[1]); w.y = pk2(v[2], v[3]); w.z = pk2(v[4], v[5]); w.w = pk2(v[6], v[7]); return w; }

__device__ __forceinline__ void transpose_tile(unsigned char* lds, const float* src, int ld, int col0, int ncols_valid, int k0, bf16_t* dst, int dstK, int n0, const float* kscale) {
    float* tile = (float*)lds;
    const int tid = threadIdx.x;
    const int kk = tid >> 4, c4 = (tid & 15) * 4;
#pragma unroll
    for (int pass = 0; pass < 2; ++pass) {
        const int k = kk + pass * 32;
        float4 v = make_float4(0.f, 0.f, 0.f, 0.f);
        if (c4 < ncols_valid) v = *(const float4*)(src + (size_t)(k0 + k) * ld + col0 + c4);
        if (kscale) { const float s = kscale[k0 + k]; v.x *= s; v.y *= s; v.z *= s; v.w *= s; }
        tile[k * 65 + c4 + 0] = v.x; tile[k * 65 + c4 + 1] = v.y; tile[k * 65 + c4 + 2] = v.z; tile[k * 65 + c4 + 3] = v.w;
    }
    __syncthreads();
    const int n = tid >> 3, kg = tid & 7;
    float v[8];
#pragma unroll
    for (int j = 0; j < 8; ++j) v[j] = tile[(kg * 8 + j) * 65 + n];
    *(u32x4*)(dst + (size_t)(n0 + n) * dstK + k0 + kg * 8) = pack8(v);
    __syncthreads();
}

__device__ __forceinline__ void p0_prologue(const Params& p, unsigned char* lds) {
    const int tid = threadIdx.x, lane = tid & 63, wave = tid >> 6;
    const int G = gridDim.x, bid = blockIdx.x;
    bf16_t* H = (bf16_t*)p.out;
    { float4 wv[4];
#pragma unroll
      for (int i = 0; i < 4; ++i) wv[i] = *(const float4*)(p.pre_norm_w + i * 256 + lane * 4);
      float4 v[2][4], nv[2][4];
      const int tstep = 2 * G * 8;
#define P0_LOAD(dst, tb_) do { _Pragma("unroll") for (int k = 0; k < 2; ++k) { const int t_ = (tb_) + k * G * 8; const int tt_ = t_ < TT ? t_ : TT - 1; \
          const float* xr_ = tt_ < TP ? p.x_prompt + (size_t)tt_ * DM : p.x_sample + (size_t)(tt_ - TP) * DM; \
          _Pragma("unroll") for (int i = 0; i < 4; ++i) dst[k][i] = *(const float4*)(xr_ + i * 256 + lane * 4); } } while (0)
      int tb = bid * 8 + wave;
      if (tb < TT) P0_LOAD(v, tb);
      for (; tb < TT; tb += tstep) {
        if (tb + tstep < TT) P0_LOAD(nv, tb + tstep);
#pragma unroll
        for (int k = 0; k < 2; ++k) { const int t = tb + k * G * 8; if (t < TT) {
            float ss = 0.f;
#pragma unroll
            for (int i = 0; i < 4; ++i) ss += v[k][i].x * v[k][i].x + v[k][i].y * v[k][i].y + v[k][i].z * v[k][i].z + v[k][i].w * v[k][i].w;
#pragma unroll
            for (int o = 32; o >= 1; o >>= 1) ss += __shfl_xor(ss, o);
            const float r = rsqrtf(ss * (1.0f / 1024.0f) + 1e-6f);
#pragma unroll
            for (int i = 0; i < 4; ++i) { u32x2 o; o.x = pk2(v[k][i].x * r * wv[i].x, v[k][i].y * r * wv[i].y); o.y = pk2(v[k][i].z * r * wv[i].z, v[k][i].w * r * wv[i].w);
                *(u32x2*)(H + (size_t)t * DM + i * 256 + lane * 4) = o; } } }
#pragma unroll
        for (int k = 0; k < 2; ++k)
#pragma unroll
            for (int i = 0; i < 4; ++i) v[k][i] = nv[k][i];
      }
#undef P0_LOAD
    }
    bf16_t* WIN = (bf16_t*)(p.ws + W_WIN); bf16_t* WG = (bf16_t*)(p.ws + W_WG); bf16_t* WAO = (bf16_t*)(p.ws + W_WAO);
    bf16_t* WSO = (bf16_t*)(p.ws + W_WSO); bf16_t* WOUT = (bf16_t*)(p.ws + W_WOUT);
    constexpr int J0 = 1920, J1 = J0 + 16, J2 = J1 + 512, J3 = J2 + 256, J4 = J3 + 512, J5 = J4 + 256;
    {
        float* tile = (float*)lds;
        const int kk = tid >> 4, c4 = (tid & 15) * 4, tn = tid >> 3, tkg = tid & 7;
        const float* src = nullptr; int ld = 0, col0 = 0, valid = 0, k0 = 0, dstK = 0, n0 = 0; bf16_t* dst = nullptr; const float* kscale = nullptr;
#define TJ_DECODE(j) do { \
        if ((j) < J0) { const int nt = (j) >> 4, kt = (j) & 15; src = p.w_in; ld = IN_W; col0 = nt * 64; valid = 64; k0 = kt * 64; dst = WIN; dstK = 1024; n0 = nt * 64; kscale = nullptr; } \
        else if ((j) < J1) { const int kt = (j) - J0; src = p.w_in; ld = IN_W; col0 = 7680; valid = 32; k0 = kt * 64; dst = WIN; dstK = 1024; n0 = 7680; kscale = nullptr; } \
        else if ((j) < J2) { const int jj = (j) - J1, nt = jj >> 4, kt = jj & 15; src = p.w_in; ld = IN_W; col0 = 7712 + nt * 64; valid = 64; k0 = kt * 64; dst = WG; dstK = 1024; n0 = nt * 64; kscale = nullptr; } \
        else if ((j) < J3) { const int jj = (j) - J2, nt = jj >> 4, kt = jj & 15; src = p.w_attn_o; ld = 1024; col0 = nt * 64; valid = 64; k0 = kt * 64; dst = WAO; dstK = 1024; n0 = nt * 64; kscale = nullptr; } \
        else if ((j) < J4) { const int jj = (j) - J3, nt = jj >> 5, kt = jj & 31; src = p.w_ssm_o; ld = 1024; col0 = nt * 64; valid = 64; k0 = kt * 64; dst = WSO; dstK = 2048; n0 = nt * 64; kscale = p.ssm_norm_w; } \
        else { const int jj = (j) - J4, nt = jj >> 4, kt = jj & 15; src = p.w_out; ld = 1024; col0 = nt * 64; valid = 64; k0 = kt * 64; dst = WOUT; dstK = 1024; n0 = nt * 64; kscale = nullptr; } } while (0)
#define TJ_LOAD() do { _Pragma("unroll") for (int ps = 0; ps < 2; ++ps) { const int k = kk + ps * 32; float4 v_ = make_float4(0.f, 0.f, 0.f, 0.f); \
            if (c4 < valid) v_ = *(const float4*)(src + (size_t)(k0 + k) * ld + col0 + c4); \
            if (kscale) { const float s_ = kscale[k0 + k]; v_.x *= s_; v_.y *= s_; v_.z *= s_; v_.w *= s_; } tv[ps] = v_; } } while (0)
        float4 tv[2];
        int j = bid;
        if (j < J5) { TJ_DECODE(j); TJ_LOAD(); }
        for (; j < J5; j += G) {
#pragma unroll
            for (int ps = 0; ps < 2; ++ps) { const int k = kk + ps * 32; tile[k * 65 + c4 + 0] = tv[ps].x; tile[k * 65 + c4 + 1] = tv[ps].y; tile[k * 65 + c4 + 2] = tv[ps].z; tile[k * 65 + c4 + 3] = tv[ps].w; }
            __syncthreads();
            bf16_t* const dptr = dst + (size_t)(n0 + tn) * dstK + k0 + tkg * 8;
            if (j + G < J5) { TJ_DECODE(j + G); TJ_LOAD(); }
            float v[8];
#pragma unroll
            for (int e = 0; e < 8; ++e) v[e] = tile[(tkg * 8 + e) * 65 + tn];
            *(u32x4*)dptr = pack8(v);
            __syncthreads();
        }
#undef TJ_DECODE
#undef TJ_LOAD
    }
    const size_t gtid = (size_t)bid * NTHR + tid, gstride = (size_t)G * NTHR;
    { u32x4* z = (u32x4*)(WIN + (size_t)7744 * 1024); const size_t n16 = (size_t)192 * 1024 * 2 / 16; const u32x4 zero = {0u, 0u, 0u, 0u};
      for (size_t i = gtid; i < n16; i += gstride) z[i] = zero; }
    { float2* rope = (float2*)(p.ws + W_ROPE);
      for (size_t i = gtid; i < 8224 * 8; i += gstride) { const int pi = (int)(i >> 3), j = (int)(i & 7); const int pos = pi < 8192 ? pi : 2048 + (pi - 8192);
          const float inv = (float)pow(500000.0, -(double)j / 8.0); const float ang = (float)pos * inv; double s, c; sincos((double)ang, &s, &c); rope[i] = make_float2((float)c, (float)s); } }
}

struct EpiInProj {
    static constexpr bool PERM = true, AFTER_DRAIN = false;
    unsigned char* ws; const float* dt_bias;
    __device__ __forceinline__ void operator()(const f32x4 (&acc)[2][2][4][2], const pg8::Unit& u, int wr, int wc, int fr, int fq) const {
        const int pn = u.pn; const int row0 = u.pm * 256 + wr * 64 + fr;
        if (pn == 30) {
            if (wc == 0) { float* DT = (float*)(ws + W_DT);
#pragma unroll
                for (int n = 0; n < 2; ++n) { const f32x4 bv = *(const f32x4*)(dt_bias + 8 * fq + 4 * n);
#pragma unroll
                    for (int ai = 0; ai < 2; ++ai)
#pragma unroll
                        for (int m = 0; m < 4; ++m) { f32x4 v = acc[ai][0][m][n] + bv;
#pragma unroll
                            for (int j = 0; j < 4; ++j) v[j] = v[j] > 20.f ? v[j] : log1pf(__expf(v[j]));
                            *(f32x4*)(DT + (size_t)(row0 + ai * 128 + m * 16) * 32 + 8 * fq + 4 * n) = v; } } }
            return;
        }
        bf16_t* base; int ldc, colt;
        if (pn < 4) { base = (bf16_t*)(ws + W_Q); ldc = 1024; colt = pn * 256; }
        else if (pn == 4) { base = (bf16_t*)(ws + W_K); ldc = 256; colt = 0; }
        else if (pn == 5) { base = (bf16_t*)(ws + W_V); ldc = 256; colt = 0; }
        else if (pn < 10) { base = (bf16_t*)(ws + W_G); ldc = 1024; colt = (pn - 6) * 256; }
        else if (pn < 18) { base = (bf16_t*)(ws + W_Z); ldc = 2048; colt = (pn - 10) * 256; }
        else { base = (bf16_t*)(ws + W_XBC); ldc = 3072; colt = (pn - 18) * 256; }
        const int col0 = colt + wc * 32 + 8 * fq;
#pragma unroll
        for (int ai = 0; ai < 2; ++ai)
#pragma unroll
            for (int m = 0; m < 4; ++m) { bf16_t* rowp = base + (size_t)(row0 + ai * 128 + m * 16) * ldc + col0;
#pragma unroll
                for (int bj = 0; bj < 2; ++bj) { const f32x4 v0 = acc[ai][bj][m][0], v1 = acc[ai][bj][m][1];
                    u32x4 w; w.x = pk2(v0[0], v0[1]); w.y = pk2(v0[2], v0[3]); w.z = pk2(v1[0], v1[1]); w.w = pk2(v1[2], v1[3]);
                    *(u32x4*)(rowp + bj * 128) = w; } }
    }
};
template <int MODE> struct EpiMerge {
    static constexpr bool PERM = true, AFTER_DRAIN = false;
    bf16_t* O; const bf16_t* G1;
    __device__ __forceinline__ void operator()(const f32x4 (&acc)[2][2][4][2], const pg8::Unit& u, int wr, int wc, int fr, int fq) const {
        const int row0 = u.pm * 256 + wr * 64 + fr; const int col0 = u.pn * 256 + wc * 32 + 8 * fq;
#pragma unroll
        for (int ai = 0; ai < 2; ++ai) {
            u32x4 gq[4][2], oq[4][2];
            if (MODE != 0) {
#pragma unroll
                for (int m = 0; m < 4; ++m)
#pragma unroll
                    for (int bj = 0; bj < 2; ++bj) { const size_t off = (size_t)(row0 + ai * 128 + m * 16) * 1024 + col0 + bj * 128;
                        gq[m][bj] = *(const u32x4*)(G1 + off); if (MODE == 2) oq[m][bj] = *(const u32x4*)(O + off); }
            }
#pragma unroll
            for (int m = 0; m < 4; ++m)
#pragma unroll
                for (int bj = 0; bj < 2; ++bj) { const size_t off = (size_t)(row0 + ai * 128 + m * 16) * 1024 + col0 + bj * 128;
                    const f32x4 v0 = acc[ai][bj][m][0], v1 = acc[ai][bj][m][1];
                    float v[8] = {v0[0], v0[1], v0[2], v0[3], v1[0], v1[1], v1[2], v1[3]};
                    if (MODE == 0) {
#pragma unroll
                        for (int j = 0; j < 8; ++j) v[j] = sigmoidf_(v[j]);
                    } else { float g[8]; unpack8(gq[m][bj], g);
                        if (MODE == 1) {
#pragma unroll
                            for (int j = 0; j < 8; ++j) v[j] = g[j] * v[j];
                        } else { float o[8]; unpack8(oq[m][bj], o);
#pragma unroll
                            for (int j = 0; j < 8; ++j) v[j] = o[j] + g[j] * v[j]; } }
                    *(u32x4*)(O + off) = pack8(v); }
        }
    }
};
template <int ADD> struct EpiOutT {
    static constexpr bool PERM = true, AFTER_DRAIN = false;
    bf16_t* out; float* ssq;
    __device__ __forceinline__ void operator()(const f32x4 (&acc)[2][2][4][2], const pg8::Unit& u, int wr, int wc, int fr, int fq) const {
        const int row0 = u.pm * 256 + wr * 64 + fr, col0 = u.pn * 256 + wc * 32 + 8 * fq;
#pragma unroll
        for (int ai = 0; ai < 2; ++ai)
#pragma unroll
            for (int m = 0; m < 4; ++m) { const int row = row0 + ai * 128 + m * 16; bf16_t* rowp = out + (size_t)row * 1024 + col0;
                float s = 0.f;
#pragma unroll
                for (int bj = 0; bj < 2; ++bj) { const f32x4 v0 = acc[ai][bj][m][0], v1 = acc[ai][bj][m][1];
                    float v[8] = {v0[0], v0[1], v0[2], v0[3], v1[0], v1[1], v1[2], v1[3]};
                    if (ADD) { float o[8]; unpack8(*(const u32x4*)(rowp + bj * 128), o);
#pragma unroll
                        for (int j = 0; j < 8; ++j) v[j] += o[j]; }
#pragma unroll
                    for (int j = 0; j < 8; ++j) s += v[j] * v[j];
                    *(u32x4*)(rowp + bj * 128) = pack8(v); }
                s += __shfl_xor(s, 16); s += __shfl_xor(s, 32);
                if (fq == 0) ssq[(size_t)row * 16 + u.pn * 4 + wc] = s; }
    }
};

constexpr int KS_STRIDE = 72;
constexpr int VT_STRIDE = 200;
constexpr int KS_OFF = 0, VT_OFF = 192 * KS_STRIDE * 2;

__device__ __forceinline__ void attn_unit(const Params& p, unsigned char* lds, const int is_sample, const int b, const int c, const int kvh) {
    const int tid = threadIdx.x, lane = tid & 63, wave = tid >> 6, fr = lane & 15, fq = lane >> 4;
    bf16_t* Q = (bf16_t*)(p.ws + W_Q); const bf16_t* K = (const bf16_t*)(p.ws + W_K); const bf16_t* V = (const bf16_t*)(p.ws + W_V);
    const bf16_t* GT = (const bf16_t*)(p.ws + W_G); const float2* rope = (const float2*)(p.ws + W_ROPE);
    bf16_t* Ks = (bf16_t*)(lds + KS_OFF); bf16_t* Vt = (bf16_t*)(lds + VT_OFF);
    int nkeys, ncache, NQ, cs; size_t tq0, tk0; int pos_q0, pos_k0;
    if (is_sample) { nkeys = 160; ncache = 128; NQ = 32; cs = 0; tq0 = (size_t)TP + b * 32; tk0 = tq0; pos_q0 = 8192; pos_k0 = 8192; }
    else { cs = c >= 2 ? c - 2 : 0; nkeys = (c - cs + 1) * 64; ncache = 0; NQ = 64; tq0 = (size_t)b * 8192 + c * 64; tk0 = (size_t)b * 8192 + cs * 64; pos_q0 = c * 64; pos_k0 = cs * 64; }
    __syncthreads();
    for (int item = tid; item < nkeys * 4; item += NTHR) {
        const int key = item >> 2, i = item & 3;
        float v[16];
        if (key < ncache) { const float* src = p.cache_k + ((size_t)(b * 128 + key) * 4 + kvh) * 64 + i * 16;
#pragma unroll
            for (int q4 = 0; q4 < 4; ++q4) { const float4 f = *(const float4*)(src + q4 * 4); v[q4 * 4] = f.x; v[q4 * 4 + 1] = f.y; v[q4 * 4 + 2] = f.z; v[q4 * 4 + 3] = f.w; }
        } else {
            const int kk = key - ncache; const bf16_t* src = K + (tk0 + kk) * 256 + kvh * 64 + i * 16;
            float a[8], bb[8]; unpack8(*(const u32x4*)src, a); unpack8(*(const u32x4*)(src + 8), bb);
            if (i == 0) { const float2* rp = rope + (size_t)(pos_k0 + kk) * 8;
#pragma unroll
                for (int j = 0; j < 8; ++j) { const float2 cssn = rp[j]; v[j] = a[j] * cssn.x - bb[j] * cssn.y; v[8 + j] = bb[j] * cssn.x + a[j] * cssn.y; }
            } else {
#pragma unroll
                for (int j = 0; j < 8; ++j) { v[j] = a[j]; v[8 + j] = bb[j]; } }
            float* dst = nullptr;
            if (is_sample) dst = p.out + O_KS + ((size_t)(b * 32 + kk) * 4 + kvh) * 64 + i * 16;
            else if (c >= 126 && kk >= (c - cs) * 64) dst = p.out + O_KP + ((size_t)(b * 128 + (c - 126) * 64 + (kk - (c - cs) * 64)) * 4 + kvh) * 64 + i * 16;
            if (dst) {
#pragma unroll
                for (int q4 = 0; q4 < 4; ++q4) *(float4*)(dst + q4 * 4) = make_float4(v[q4 * 4], v[q4 * 4 + 1], v[q4 * 4 + 2], v[q4 * 4 + 3]); }
        }
        float lo[8], hi[8];
#pragma unroll
        for (int j = 0; j < 8; ++j) { lo[j] = v[j]; hi[j] = v[8 + j]; }
        *(u32x4*)(Ks + key * KS_STRIDE + i * 16) = pack8(lo); *(u32x4*)(Ks + key * KS_STRIDE + i * 16 + 8) = pack8(hi);
    }
    for (int item = tid; item < nkeys * 8; item += NTHR) {
        const int dg = item / nkeys, key = item - dg * nkeys;
        float v[8];
        if (key < ncache) { const float* src = p.cache_v + ((size_t)(b * 128 + key) * 4 + kvh) * 64 + dg * 8;
            const float4 f0 = *(const float4*)src, f1 = *(const float4*)(src + 4); v[0] = f0.x; v[1] = f0.y; v[2] = f0.z; v[3] = f0.w; v[4] = f1.x; v[5] = f1.y; v[6] = f1.z; v[7] = f1.w;
        } else {
            const int kk = key - ncache; unpack8(*(const u32x4*)(V + (tk0 + kk) * 256 + kvh * 64 + dg * 8), v);
            float* dst = nullptr;
            if (is_sample) dst = p.out + O_VS + ((size_t)(b * 32 + kk) * 4 + kvh) * 64 + dg * 8;
            else if (c >= 126 && kk >= (c - cs) * 64) dst = p.out + O_VP + ((size_t)(b * 128 + (c - 126) * 64 + (kk - (c - cs) * 64)) * 4 + kvh) * 64 + dg * 8;
            if (dst) { *(float4*)dst = make_float4(v[0], v[1], v[2], v[3]); *(float4*)(dst + 4) = make_float4(v[4], v[5], v[6], v[7]); }
        }
#pragma unroll
        for (int e = 0; e < 8; ++e) Vt[(dg * 8 + e) * VT_STRIDE + key] = f2bf(v[e]);
    }
    __syncthreads();
    const int nqt_h = NQ >> 4, nqt = 4 * nqt_h, nkt = nkeys >> 4;
    for (int qt = wave; qt < nqt; qt += 8) {
        const int g = qt / nqt_h, r0 = (qt - g * nqt_h) * 16, hq = kvh * 4 + g;
        bf16_t* qp = Q + (tq0 + r0 + fr) * 1024 + hq * 64 + fq * 8;
        bf16x8 q0 = *(const bf16x8*)qp, q1 = *(const bf16x8*)(qp + 32);
        { const float2* rp = rope + (size_t)(pos_q0 + r0 + fr) * 8;
#pragma unroll
          for (int j = 0; j < 8; ++j) { const float mine = bf2f_s(q0[j]); const float other = __shfl_xor(mine, 16); const float2 cssn = rp[j];
              const float nv = (fq == 0) ? mine * cssn.x - other * cssn.y : mine * cssn.x + other * cssn.y;
              if (fq < 2) q0[j] = (short)f2bf(nv); } }
        f32x4 sacc[12];
#pragma unroll
        for (int kt = 0; kt < 12; ++kt) { sacc[kt] = (f32x4){0.f, 0.f, 0.f, 0.f};
            if (kt < nkt) { const bf16_t* kp = Ks + (kt * 16 + fr) * KS_STRIDE + fq * 8;
                sacc[kt] = __builtin_amdgcn_mfma_f32_16x16x32_bf16(*(const bf16x8*)kp, q0, sacc[kt], 0, 0, 0);
                sacc[kt] = __builtin_amdgcn_mfma_f32_16x16x32_bf16(*(const bf16x8*)(kp + 32), q1, sacc[kt], 0, 0, 0); } }
        const float sk = p.sinks[hq];
        float m = sk;
#pragma unroll
        for (int kt = 0; kt < 12; ++kt) if (kt < nkt) {
#pragma unroll
            for (int r = 0; r < 4; ++r) { sacc[kt][r] *= 0.125f; m = fmaxf(m, sacc[kt][r]); } }
        m = fmaxf(m, __shfl_xor(m, 16)); m = fmaxf(m, __shfl_xor(m, 32));
        float sum = 0.f;
#pragma unroll
        for (int kt = 0; kt < 12; ++kt) if (kt < nkt) {
#pragma unroll
            for (int r = 0; r < 4; ++r) { const float e = __expf(sacc[kt][r] - m); sacc[kt][r] = e; sum += e; } }
        sum += __shfl_xor(sum, 16); sum += __shfl_xor(sum, 32);
        const float inv = 1.0f / (sum + __expf(sk - m));
        f32x4 oacc[4];
#pragma unroll
        for (int dt = 0; dt < 4; ++dt) oacc[dt] = (f32x4){0.f, 0.f, 0.f, 0.f};
#pragma unroll
        for (int kk = 0; kk < 6; ++kk) if (2 * kk < nkt) {
            union { bf16x8 v; unsigned u[4]; } pb;
            pb.u[0] = pk2(sacc[2 * kk][0], sacc[2 * kk][1]); pb.u[1] = pk2(sacc[2 * kk][2], sacc[2 * kk][3]);
            pb.u[2] = pk2(sacc[2 * kk + 1][0], sacc[2 * kk + 1][1]); pb.u[3] = pk2(sacc[2 * kk + 1][2], sacc[2 * kk + 1][3]);
#pragma unroll
            for (int dt = 0; dt < 4; ++dt) { const bf16_t* vp = Vt + (dt * 16 + fr) * VT_STRIDE + kk * 32 + fq * 4;
                union { bf16x8 v; u32x2 h[2]; } va; va.h[0] = *(const u32x2*)vp; va.h[1] = *(const u32x2*)(vp + 16);
                oacc[dt] = __builtin_amdgcn_mfma_f32_16x16x32_bf16(va.v, pb.v, oacc[dt], 0, 0, 0); } }
#pragma unroll
        for (int dt = 0; dt < 4; ++dt) { const size_t off = (tq0 + r0 + fr) * 1024 + hq * 64 + dt * 16 + fq * 4;
            const u32x2 gw = *(const u32x2*)(GT + off);
            const float g0 = __uint_as_float(gw.x << 16), g1 = __uint_as_float(gw.x & 0xffff0000u), g2 = __uint_as_float(gw.y << 16), g3 = __uint_as_float(gw.y & 0xffff0000u);
            u32x2 o; o.x = pk2(oacc[dt][0] * inv * siluf_(g0), oacc[dt][1] * inv * siluf_(g1)); o.y = pk2(oacc[dt][2] * inv * siluf_(g2), oacc[dt][3] * inv * siluf_(g3));
            *(u32x2*)(Q + off) = o; }
    }
}

constexpr int K2_SLOT = 64 * KS_STRIDE;
constexpr int V2_STRIDE = 264;
constexpr int K2_OFF = 0, V2_OFF = 4 * K2_SLOT * 2;

__device__ __forceinline__ void attn_run(const Params& p, unsigned char* lds, const int b, const int kvh, const int c0) {
    const int tid = threadIdx.x, lane = tid & 63, wave = tid >> 6, fr = lane & 15, fq = lane >> 4;
    bf16_t* Q = (bf16_t*)(p.ws + W_Q); const bf16_t* K = (const bf16_t*)(p.ws + W_K); const bf16_t* V = (const bf16_t*)(p.ws + W_V);
    const bf16_t* GT = (const bf16_t*)(p.ws + W_G); const float2* rope = (const float2*)(p.ws + W_ROPE);
    bf16_t* Ks = (bf16_t*)(lds + K2_OFF); bf16_t* Vt = (bf16_t*)(lds + V2_OFF);
    const int kkey = tid >> 2, ki = tid & 3;
    const int vkey = tid & 63, vdg = tid >> 6;
    const size_t tb0 = (size_t)b * 8192;
    u32x4 rka = {0u, 0u, 0u, 0u}, rkb = rka, rv = rka; f32x4 rkr[4];
#pragma unroll
    for (int j = 0; j < 4; ++j) rkr[j] = (f32x4){1.f, 0.f, 1.f, 0.f};
#define A2_LOAD(cc) do { if (tid < 256) { const bf16_t* s_ = K + (tb0 + (size_t)(cc) * 64 + kkey) * 256 + kvh * 64 + ki * 16; rka = *(const u32x4*)s_; rkb = *(const u32x4*)(s_ + 8); \
            if (ki == 0) { const f32x4* rp4_ = (const f32x4*)(rope + (size_t)((cc) * 64 + kkey) * 8); _Pragma("unroll") for (int j = 0; j < 4; ++j) rkr[j] = rp4_[j]; } } \
        rv = *(const u32x4*)(V + (tb0 + (size_t)(cc) * 64 + vkey) * 256 + kvh * 64 + vdg * 8); } while (0)
#define A2_WRITE(cc) do { const int sl_ = (cc) & 3; \
        if (tid < 256) { float a_[8], b_[8]; unpack8(rka, a_); unpack8(rkb, b_); \
            if (ki == 0) { \
                _Pragma("unroll") for (int j = 0; j < 8; ++j) { const float cc_ = rkr[j >> 1][(j & 1) * 2], ss_ = rkr[j >> 1][(j & 1) * 2 + 1]; const float x1_ = a_[j], x2_ = b_[j]; a_[j] = x1_ * cc_ - x2_ * ss_; b_[j] = x2_ * cc_ + x1_ * ss_; } } \
            if ((cc) >= 126) { float* d_ = p.out + O_KP + ((size_t)(b * 128 + ((cc) - 126) * 64 + kkey) * 4 + kvh) * 64 + ki * 16; \
                *(float4*)d_ = make_float4(a_[0], a_[1], a_[2], a_[3]); *(float4*)(d_ + 4) = make_float4(a_[4], a_[5], a_[6], a_[7]); *(float4*)(d_ + 8) = make_float4(b_[0], b_[1], b_[2], b_[3]); *(float4*)(d_ + 12) = make_float4(b_[4], b_[5], b_[6], b_[7]); } \
            *(u32x4*)(Ks + sl_ * K2_SLOT + kkey * KS_STRIDE + ki * 16) = pack8(a_); *(u32x4*)(Ks + sl_ * K2_SLOT + kkey * KS_STRIDE + ki * 16 + 8) = pack8(b_); } \
        { if ((cc) >= 126) { float v_[8]; unpack8(rv, v_); float* d_ = p.out + O_VP + ((size_t)(b * 128 + ((cc) - 126) * 64 + vkey) * 4 + kvh) * 64 + vdg * 8; \
              *(float4*)d_ = make_float4(v_[0], v_[1], v_[2], v_[3]); *(float4*)(d_ + 4) = make_float4(v_[4], v_[5], v_[6], v_[7]); } \
          const unsigned vw_[4] = {rv.x, rv.y, rv.z, rv.w}; \
          _Pragma("unroll") for (int e = 0; e < 8; ++e) Vt[(vdg * 8 + e) * V2_STRIDE + sl_ * 64 + vkey] = (bf16_t)((e & 1) ? (vw_[e >> 1] >> 16) : (vw_[e >> 1] & 0xffffu)); } } while (0)
    __syncthreads();
    for (int cc = c0 - 2; cc <= c0; ++cc) if (cc >= 0) { A2_LOAD(cc); A2_WRITE(cc); }
    if (c0 + 1 < 128) A2_LOAD(c0 + 1);
    for (int u = 0; u < 16; ++u) {
        const int c = c0 + u;
        __syncthreads();
        const size_t tq0 = tb0 + (size_t)c * 64;
        bf16x8 q0v[2], q1v[2]; f32x4 csv[2][4];
#pragma unroll
        for (int qi = 0; qi < 2; ++qi) { const int qt = wave * 2 + qi; const bf16_t* qp = Q + (tq0 + (qt & 3) * 16 + fr) * 1024 + (kvh * 4 + (qt >> 2)) * 64 + fq * 8; q0v[qi] = *(const bf16x8*)qp; q1v[qi] = *(const bf16x8*)(qp + 32);
            const f32x4* rp4 = (const f32x4*)(rope + (size_t)(c * 64 + (qt & 3) * 16 + fr) * 8);
#pragma unroll
            for (int j = 0; j < 4; ++j) csv[qi][j] = rp4[j]; }
        if (u + 1 < 16) A2_WRITE(c + 1);
        if (u + 2 < 16) A2_LOAD(c + 2);
#pragma unroll
        for (int qi = 0; qi < 2; ++qi) {
            const int qt = wave * 2 + qi, g = qt >> 2, r0 = (qt & 3) * 16, hq = kvh * 4 + g;
            bf16x8 q0 = q0v[qi], q1 = q1v[qi];
            u32x2 gw[4];
#pragma unroll
            for (int dt = 0; dt < 4; ++dt) gw[dt] = *(const u32x2*)(GT + (tq0 + r0 + fr) * 1024 + hq * 64 + dt * 16 + fq * 4);
            {
#pragma unroll
              for (int j = 0; j < 8; ++j) { const float mine = bf2f_s(q0[j]); const float other = __shfl_xor(mine, 16); const float cs_c = csv[qi][j >> 1][(j & 1) * 2], cs_s = csv[qi][j >> 1][(j & 1) * 2 + 1];
                  const float nv = (fq == 0) ? mine * cs_c - other * cs_s : mine * cs_c + other * cs_s;
                  if (fq < 2) q0[j] = (short)f2bf(nv); } }
            f32x4 sacc[12];
#pragma unroll
            for (int kt = 0; kt < 12; ++kt) { sacc[kt] = (f32x4){0.f, 0.f, 0.f, 0.f}; const int cc = c - 2 + (kt >> 2);
                if (cc >= 0) { const bf16_t* kp = Ks + (cc & 3) * K2_SLOT + ((kt & 3) * 16 + fr) * KS_STRIDE + fq * 8;
                    sacc[kt] = __builtin_amdgcn_mfma_f32_16x16x32_bf16(*(const bf16x8*)kp, q0, sacc[kt], 0, 0, 0);
                    sacc[kt] = __builtin_amdgcn_mfma_f32_16x16x32_bf16(*(const bf16x8*)(kp + 32), q1, sacc[kt], 0, 0, 0); } }
            const float sk = p.sinks[hq];
            float m = sk;
#pragma unroll
            for (int kt = 0; kt < 12; ++kt) if (c - 2 + (kt >> 2) >= 0) {
#pragma unroll
                for (int r = 0; r < 4; ++r) { sacc[kt][r] *= 0.125f; m = fmaxf(m, sacc[kt][r]); } }
            m = fmaxf(m, __shfl_xor(m, 16)); m = fmaxf(m, __shfl_xor(m, 32));
            float sum = 0.f;
#pragma unroll
            for (int kt = 0; kt < 12; ++kt) if (c - 2 + (kt >> 2) >= 0) {
#pragma unroll
                for (int r = 0; r < 4; ++r) { const float e = __expf(sacc[kt][r] - m); sacc[kt][r] = e; sum += e; } }
            sum += __shfl_xor(sum, 16); sum += __shfl_xor(sum, 32);
            const float inv = 1.0f / (sum + __expf(sk - m));
            f32x4 oacc[4];
#pragma unroll
            for (int dt = 0; dt < 4; ++dt) oacc[dt] = (f32x4){0.f, 0.f, 0.f, 0.f};
#pragma unroll
            for (int kk = 0; kk < 6; ++kk) { const int cc = c - 2 + (kk >> 1); if (cc >= 0) {
                union { bf16x8 v; unsigned u[4]; } pb;
                pb.u[0] = pk2(sacc[2 * kk][0], sacc[2 * kk][1]); pb.u[1] = pk2(sacc[2 * kk][2], sacc[2 * kk][3]);
                pb.u[2] = pk2(sacc[2 * kk + 1][0], sacc[2 * kk + 1][1]); pb.u[3] = pk2(sacc[2 * kk + 1][2], sacc[2 * kk + 1][3]);
#pragma unroll
                for (int dt = 0; dt < 4; ++dt) { const bf16_t* vp = Vt + (dt * 16 + fr) * V2_STRIDE + (cc & 3) * 64 + (kk & 1) * 32 + fq * 4;
                    union { bf16x8 v; u32x2 h[2]; } va; va.h[0] = *(const u32x2*)vp; va.h[1] = *(const u32x2*)(vp + 16);
                    oacc[dt] = __builtin_amdgcn_mfma_f32_16x16x32_bf16(va.v, pb.v, oacc[dt], 0, 0, 0); } } }
#pragma unroll
            for (int dt = 0; dt < 4; ++dt) { const size_t off = (tq0 + r0 + fr) * 1024 + hq * 64 + dt * 16 + fq * 4;
                const float g0 = __uint_as_float(gw[dt].x << 16), g1 = __uint_as_float(gw[dt].x & 0xffff0000u), g2 = __uint_as_float(gw[dt].y << 16), g3 = __uint_as_float(gw[dt].y & 0xffff0000u);
                u32x2 o; o.x = pk2(oacc[dt][0] * inv * siluf_(g0), oacc[dt][1] * inv * siluf_(g1)); o.y = pk2(oacc[dt][2] * inv * siluf_(g2), oacc[dt][3] * inv * siluf_(g3));
                *(u32x2*)(Q + off) = o; }
        }
    }
#undef A2_LOAD
#undef A2_WRITE
}

__device__ __forceinline__ void grid_bar(unsigned* word, unsigned G);
typedef unsigned u32x3 __attribute__((ext_vector_type(3)));
__device__ __forceinline__ void unpack6(const u32x3 w, float (&v)[6]) {
    v[0] = __uint_as_float(w.x << 16); v[1] = __uint_as_float(w.x & 0xffff0000u); v[2] = __uint_as_float(w.y << 16); v[3] = __uint_as_float(w.y & 0xffff0000u); v[4] = __uint_as_float(w.z << 16); v[5] = __uint_as_float(w.z & 0xffff0000u);
}
__device__ __forceinline__ void conv_rows(bf16_t* rowp0, const int nrows, float (&w0)[6], float (&w1)[6], float (&w2)[6], const float (&cwt)[4][6], const float (&cb)[6], float* tail_dst) {
    u32x3 cur[8], n1[8], n2[8];
#pragma unroll
    for (int k = 0; k < 8; ++k) { cur[k] = *(const u32x3*)(rowp0 + (size_t)k * 3072); n1[k] = *(const u32x3*)(rowp0 + (size_t)(8 + k) * 3072); }
    for (int r4 = 0; r4 < nrows; r4 += 8) {
        const bool more = r4 + 16 < nrows;
#pragma unroll
        for (int k = 0; k < 8; ++k) n2[k] = more ? *(const u32x3*)(rowp0 + (size_t)(r4 + 16 + k) * 3072) : n1[k];
#pragma unroll
        for (int k = 0; k < 8; ++k) {
            float x3[6]; unpack6(cur[k], x3);
            if (tail_dst && r4 + k >= nrows - 3) { float* d = tail_dst + (size_t)(r4 + k - (nrows - 3)) * 3072; *(float2*)d = make_float2(x3[0], x3[1]); *(float2*)(d + 2) = make_float2(x3[2], x3[3]); *(float2*)(d + 4) = make_float2(x3[4], x3[5]); }
            float y[6];
#pragma unroll
            for (int e = 0; e < 6; ++e) { y[e] = cb[e] + cwt[0][e] * w0[e] + cwt[1][e] * w1[e] + cwt[2][e] * w2[e] + cwt[3][e] * x3[e]; y[e] = siluf_(y[e]); w0[e] = w1[e]; w1[e] = w2[e]; w2[e] = x3[e]; }
            u32x3 o; o.x = pk2(y[0], y[1]); o.y = pk2(y[2], y[3]); o.z = pk2(y[4], y[5]);
            *(u32x3*)(rowp0 + (size_t)(r4 + k) * 3072) = o;
        }
#pragma unroll
        for (int k = 0; k < 8; ++k) { cur[k] = n1[k]; n1[k] = n2[k]; }
    }
}
__device__ __forceinline__ void conv_prepass(const Params& p, unsigned* barword, const int G) {
    const int tid = threadIdx.x, bid = blockIdx.x;
    bf16_t* XBC = (bf16_t*)(p.ws + W_XBC);
    const int ch0 = tid * 6;
    u32x3 h0 = {0u, 0u, 0u}, h1 = h0, h2 = h0;
    if (bid < 256) {
        const int b = bid & 7, blk = bid >> 3; const size_t rbase = (size_t)b * 8192 + (size_t)blk * 256;
        if (blk > 0) { h0 = *(const u32x3*)(XBC + (rbase - 3) * 3072 + ch0); h1 = *(const u32x3*)(XBC + (rbase - 2) * 3072 + ch0); h2 = *(const u32x3*)(XBC + (rbase - 1) * 3072 + ch0); }
    }
    grid_bar(barword, (unsigned)G);
    float cwt[4][6], cb[6];
#pragma unroll
    for (int t = 0; t < 4; ++t)
#pragma unroll
        for (int e = 0; e < 6; e += 2) { const float2 a = *(const float2*)(p.conv_w + t * 3072 + ch0 + e); cwt[t][e] = a.x; cwt[t][e + 1] = a.y; }
#pragma unroll
    for (int e = 0; e < 6; e += 2) { const float2 a = *(const float2*)(p.conv_b + ch0 + e); cb[e] = a.x; cb[e + 1] = a.y; }
    if (bid < 256) {
        const int b = bid & 7, blk = bid >> 3; const size_t rbase = (size_t)b * 8192 + (size_t)blk * 256;
        float w0[6], w1[6], w2[6]; unpack6(h0, w0); unpack6(h1, w1); unpack6(h2, w2);
        conv_rows(XBC + rbase * 3072 + ch0, 256, w0, w1, w2, cwt, cb, blk == 31 ? p.out + O_CP + (size_t)b * 3 * 3072 + ch0 : nullptr);
    }
    if (bid < 16) {
        const int sb = bid; const float* sc = p.state_conv + (size_t)sb * 3 * 3072 + ch0;
        float w0[6], w1[6], w2[6];
#pragma unroll
        for (int e = 0; e < 6; ++e) { w0[e] = sc[e]; w1[e] = sc[3072 + e]; w2[e] = sc[2 * 3072 + e]; }
        conv_rows(XBC + ((size_t)TP + sb * 32) * 3072 + ch0, 32, w0, w1, w2, cwt, cb, p.out + O_CS + (size_t)sb * 3 * 3072 + ch0);
    }
}

constexpr int CS_OFF = 0, BS_OFF = 17408, BT_OFF = 34816, XT_OFF = 53248, MS_OFF = 62464, HS_OFF = 71680, YS_OFF = 89088, SC_OFF = 106496;
constexpr int ST136 = 136, ST72 = 72, YS_ST = 68;

__device__ __forceinline__ void ssd_seq(const Params& p, unsigned char* lds, const int is_sample, const int b, const int h) {
    const int tid = threadIdx.x, lane = tid & 63, wave = tid >> 6, fr = lane & 15, fq = lane >> 4;
    const int g = h >> 3;
    const bf16_t* XBC = (const bf16_t*)(p.ws + W_XBC); bf16_t* Z = (bf16_t*)(p.ws + W_Z); const float* DT = (const float*)(p.ws + W_DT); float* SSQG = (float*)(p.ws + W_SSQG);
    bf16_t* Cs = (bf16_t*)(lds + CS_OFF); bf16_t* Bs = (bf16_t*)(lds + BS_OFF); bf16_t* Bt = (bf16_t*)(lds + BT_OFF); bf16_t* Xt = (bf16_t*)(lds + XT_OFF);
    bf16_t* Ms = (bf16_t*)(lds + MS_OFF); bf16_t* Hs = (bf16_t*)(lds + HS_OFF); float* Ys = (float*)(lds + YS_OFF);
    float* dt_s = (float*)(lds + SC_OFF); float* cum_s = dt_s + 64; float* ecum_s = dt_s + 128; float* toend_s = dt_s + 192;
    const int nchunks = is_sample ? 1 : 128, Lc = is_sample ? 32 : 64;
    const size_t tseq0 = is_sample ? (size_t)TP + b * 32 : (size_t)b * 8192;
    const float a_h = -__expf(p.a_log[h]); const float d_h = p.d_skip[h];
    const int xrow = tid >> 3, xcg = tid & 7;
    const int brow = tid >> 4, bcg = tid & 15;
    const int erow = tid >> 3, epg = tid & 7;
    const int pt = wave & 3, nt0 = (wave >> 2) * 4, it = wave >> 1;
    f32x4 Hacc[4];
#pragma unroll
    for (int k = 0; k < 4; ++k)
#pragma unroll
        for (int r = 0; r < 4; ++r) Hacc[k][r] = is_sample ? p.state_ssm[((size_t)(b * 32 + h) * 64 + pt * 16 + fq * 4 + r) * 128 + (nt0 + k) * 16 + fr] : 0.f;
    u32x4 rx = {0u, 0u, 0u, 0u}, rb0 = rx, rb1 = rx, rc0 = rx, rc1 = rx, rz = rx; float rdt = 0.f;
#define SSD_LOAD_CHUNK(c) do { const size_t t0c_ = tseq0 + (size_t)(c) * 64; \
        if (xrow < Lc) rx = *(const u32x4*)(XBC + (t0c_ + xrow) * 3072 + h * 64 + xcg * 8); \
        { const bf16_t* rp_ = XBC + (t0c_ + brow) * 3072 + 2048 + g * 128 + bcg * 8; rb0 = *(const u32x4*)rp_; rc0 = *(const u32x4*)(rp_ + 512); \
          if (Lc == 64) { rb1 = *(const u32x4*)(rp_ + (size_t)32 * 3072); rc1 = *(const u32x4*)(rp_ + (size_t)32 * 3072 + 512); } } \
        if (wave == 0) rdt = lane < Lc ? DT[(t0c_ + lane) * 32 + h] : 0.f; } while (0)
#define SSD_EPILOGUE(c) do { const size_t t0e_ = tseq0 + (size_t)(c) * 64; \
        if (erow < Lc) { const float4 y0 = *(const float4*)(Ys + erow * YS_ST + epg * 8), y1 = *(const float4*)(Ys + erow * YS_ST + epg * 8 + 4); \
            float z_[8]; unpack8(rz, z_); float v_[8] = {y0.x, y0.y, y0.z, y0.w, y1.x, y1.y, y1.z, y1.w}; float ss_ = 0.f; \
            _Pragma("unroll") for (int e = 0; e < 8; ++e) { v_[e] *= siluf_(z_[e]); ss_ += v_[e] * v_[e]; } \
            *(u32x4*)(Z + (t0e_ + erow) * 2048 + h * 64 + epg * 8) = pack8(v_); \
            ss_ += __shfl_xor(ss_, 1); ss_ += __shfl_xor(ss_, 2); ss_ += __shfl_xor(ss_, 4); \
            if (epg == 0) SSQG[(t0e_ + erow) * 32 + h] = ss_; } } while (0)
#define SSD_T16(dst, w, e) dst = (bf16_t)((e) & 1 ? ((w) >> 16) : ((w) & 0xffffu))
    SSD_LOAD_CHUNK(0);
    for (int c = 0; c < nchunks; ++c) {
        __syncthreads();
        if (c > 0) SSD_EPILOGUE(c - 1);
        { const unsigned xw[4] = {rx.x, rx.y, rx.z, rx.w}, b0w[4] = {rb0.x, rb0.y, rb0.z, rb0.w}, b1w[4] = {rb1.x, rb1.y, rb1.z, rb1.w};
          const int xpos = (((xrow >> 3) ^ xcg) << 3) + (xrow & 7), bpos0 = (((brow >> 3) ^ (bcg & 7)) << 3) + (brow & 7), bpos1 = ((((brow + 32) >> 3) ^ (bcg & 7)) << 3) + (brow & 7);
#pragma unroll
          for (int e = 0; e < 8; ++e) { SSD_T16(Xt[(xcg * 8 + e) * ST72 + xpos], xw[e >> 1], e); SSD_T16(Bt[(bcg * 8 + e) * ST72 + bpos0], b0w[e >> 1], e); SSD_T16(Bt[(bcg * 8 + e) * ST72 + bpos1], b1w[e >> 1], e); }
          *(u32x4*)(Bs + brow * ST136 + bcg * 8) = rb0; *(u32x4*)(Bs + (brow + 32) * ST136 + bcg * 8) = rb1;
          *(u32x4*)(Cs + brow * ST136 + bcg * 8) = rc0; *(u32x4*)(Cs + (brow + 32) * ST136 + bcg * 8) = rc1; }
        if (wave == 0) {
            float x = rdt * a_h;
#pragma unroll
            for (int off = 1; off < 64; off <<= 1) { const float y = __shfl_up(x, off); if (lane >= off) x += y; }
            const float cl = __shfl(x, 63);
            dt_s[lane] = rdt; cum_s[lane] = x; ecum_s[lane] = __expf(x); toend_s[lane] = __expf(cl - x) * rdt;
        }
#pragma unroll
        for (int k = 0; k < 4; ++k) { const unsigned w01 = pk2(Hacc[k][0], Hacc[k][1]), w23 = pk2(Hacc[k][2], Hacc[k][3]); bf16_t* hp = Hs + (pt * 16 + fq * 4) * ST136 + (nt0 + k) * 16 + fr;
            hp[0] = (bf16_t)(w01 & 0xffffu); hp[ST136] = (bf16_t)(w01 >> 16); hp[2 * ST136] = (bf16_t)(w23 & 0xffffu); hp[3 * ST136] = (bf16_t)(w23 >> 16); }
        if (erow < Lc) rz = *(const u32x4*)(Z + (tseq0 + (size_t)c * 64 + erow) * 2048 + h * 64 + epg * 8);
        if (c + 1 < nchunks) SSD_LOAD_CHUNK(c + 1);
        __syncthreads();
#pragma unroll
        for (int jj = 0; jj < 2; ++jj) {
            const int jt = (wave & 1) * 2 + jj;
            f32x4 acc = {0.f, 0.f, 0.f, 0.f};
            if (jt <= it) {
#pragma unroll
                for (int ks = 0; ks < 4; ++ks) acc = __builtin_amdgcn_mfma_f32_16x16x32_bf16(*(const bf16x8*)(Cs + (it * 16 + fr) * ST136 + ks * 32 + fq * 8), *(const bf16x8*)(Bs + (jt * 16 + fr) * ST136 + ks * 32 + fq * 8), acc, 0, 0, 0);
            }
            const int j = jt * 16 + fr; const float cj = cum_s[j], dj = dt_s[j];
            float mv[4];
#pragma unroll
            for (int r = 0; r < 4; ++r) { const int i = it * 16 + fq * 4 + r;
                float val = (jt <= it && j <= i) ? acc[r] * __expf(cum_s[i] - cj) * dj : 0.f;
                if (i == j) val += d_h;
                mv[r] = val; }
            { const unsigned w01 = pk2(mv[0], mv[1]), w23 = pk2(mv[2], mv[3]); bf16_t* mp = Ms + (it * 16 + fq * 4) * ST72 + j;
              mp[0] = (bf16_t)(w01 & 0xffffu); mp[ST72] = (bf16_t)(w01 >> 16); mp[2 * ST72] = (bf16_t)(w23 & 0xffffu); mp[3 * ST72] = (bf16_t)(w23 >> 16); }
        }
        f32x4 accY[2];
#pragma unroll
        for (int pp = 0; pp < 2; ++pp) { const int ptile = (wave & 1) * 2 + pp; accY[pp] = (f32x4){0.f, 0.f, 0.f, 0.f};
#pragma unroll
            for (int ks = 0; ks < 4; ++ks) accY[pp] = __builtin_amdgcn_mfma_f32_16x16x32_bf16(*(const bf16x8*)(Cs + (it * 16 + fr) * ST136 + ks * 32 + fq * 8), *(const bf16x8*)(Hs + (ptile * 16 + fr) * ST136 + ks * 32 + fq * 8), accY[pp], 0, 0, 0);
#pragma unroll
            for (int r = 0; r < 4; ++r) accY[pp][r] *= ecum_s[it * 16 + fq * 4 + r]; }
        __syncthreads();
#pragma unroll
        for (int pp = 0; pp < 2; ++pp) { const int ptile = (wave & 1) * 2 + pp;
#pragma unroll
            for (int ks = 0; ks < 2; ++ks) if (ks * 32 <= it * 16 + 15)
                accY[pp] = __builtin_amdgcn_mfma_f32_16x16x32_bf16(*(const bf16x8*)(Ms + (it * 16 + fr) * ST72 + ks * 32 + fq * 8), *(const bf16x8*)(Xt + (ptile * 16 + fr) * ST72 + (((ks * 4 + fq) ^ ((ptile * 2 + (fr >> 3)) & 7)) << 3)), accY[pp], 0, 0, 0);
#pragma unroll
            for (int r = 0; r < 4; ++r) Ys[(it * 16 + fq * 4 + r) * YS_ST + ptile * 16 + fr] = accY[pp][r]; }
        { const float dec = ecum_s[63];
          bf16x8 xa[2];
#pragma unroll
          for (int ks = 0; ks < 2; ++ks) { float xv[8]; unpack8(*(const u32x4*)(Xt + (pt * 16 + fr) * ST72 + (((ks * 4 + fq) ^ ((pt * 2 + (fr >> 3)) & 7)) << 3)), xv);
              const float4 t0 = *(const float4*)(toend_s + ks * 32 + fq * 8), t1 = *(const float4*)(toend_s + ks * 32 + fq * 8 + 4);
              xv[0] *= t0.x; xv[1] *= t0.y; xv[2] *= t0.z; xv[3] *= t0.w; xv[4] *= t1.x; xv[5] *= t1.y; xv[6] *= t1.z; xv[7] *= t1.w;
              union { u32x4 u; bf16x8 v; } cvt; cvt.u = pack8(xv); xa[ks] = cvt.v; }
#pragma unroll
          for (int k = 0; k < 4; ++k) {
#pragma unroll
              for (int r = 0; r < 4; ++r) Hacc[k][r] *= dec;
#pragma unroll
              for (int ks = 0; ks < 2; ++ks) Hacc[k] = __builtin_amdgcn_mfma_f32_16x16x32_bf16(xa[ks], *(const bf16x8*)(Bt + ((nt0 + k) * 16 + fr) * ST72 + (((ks * 4 + fq) ^ (((nt0 + k) * 2 + (fr >> 3)) & 7)) << 3)), Hacc[k], 0, 0, 0); } }
    }
    __syncthreads();
    SSD_EPILOGUE(nchunks - 1);
#undef SSD_LOAD_CHUNK
#undef SSD_EPILOGUE
#undef SSD_T16
    float* hs = p.out + (is_sample ? O_SS : O_SP) + (size_t)(b * 32 + h) * 64 * 128;
#pragma unroll
    for (int k = 0; k < 4; ++k)
#pragma unroll
        for (int r = 0; r < 4; ++r) hs[(pt * 16 + fq * 4 + r) * 128 + (nt0 + k) * 16 + fr] = Hacc[k][r];
}

struct TileOrder {
    int ntiles, nwg, c;
    __device__ __forceinline__ bool next(int i, pg8::Unit& u) const { const int L = i * nwg + c; if (L >= ntiles) return false; const int q = L & 7, r = L >> 3; u.pn = r & 3; u.pm = ((r >> 2) << 3) + q; return true; }
    __device__ __forceinline__ void a_ready(const pg8::Unit&) const {}
    __device__ __forceinline__ void done(const pg8::Unit&) const {}
};
struct SampleOrder {
    int c;
    __device__ __forceinline__ bool next(int i, pg8::Unit& u) const { if (i > 0) return false; u.pm = 256 + (c >> 2); u.pn = c & 3; return true; }
    __device__ __forceinline__ void a_ready(const pg8::Unit&) const {}
    __device__ __forceinline__ void done(const pg8::Unit&) const {}
};
typedef EpiOutT<0> EpiOut;
__device__ __forceinline__ void post_rows(const Params& p, int t0, const int t1, const int tstride, const int lane) {
    const float* SSQO = (const float*)(p.ws + W_SSQO);
    float4 w[4];
#pragma unroll
    for (int i = 0; i < 4; ++i) w[i] = *(const float4*)(p.post_norm_w + i * 256 + lane * 4);
    float4 xv[2][4], nx[2][4]; u32x2 ov[2][4], no[2][4]; float sp[2], ns[2];
#define PR_LOAD(XV, OV, SP, tb_) do { _Pragma("unroll") for (int k = 0; k < 2; ++k) { const int t_ = (tb_) + k * tstride; const int tt_ = t_ < t1 ? t_ : t0; \
        const float* xr_ = tt_ < TP ? p.x_prompt + (size_t)tt_ * DM : p.x_sample + (size_t)(tt_ - TP) * DM; const bf16_t* or_ = (const bf16_t*)(p.ws + W_Z) + (size_t)tt_ * DM; \
        SP[k] = lane < 16 ? SSQO[(size_t)tt_ * 16 + lane] : 0.f; \
        _Pragma("unroll") for (int i = 0; i < 4; ++i) { XV[k][i] = *(const float4*)(xr_ + i * 256 + lane * 4); OV[k][i] = *(const u32x2*)(or_ + i * 256 + lane * 4); } } } while (0)
    int tb = t0;
    if (tb < t1) PR_LOAD(xv, ov, sp, tb);
    for (; tb < t1; tb += 2 * tstride) {
        if (tb + 2 * tstride < t1) PR_LOAD(nx, no, ns, tb + 2 * tstride);
#pragma unroll
        for (int k = 0; k < 2; ++k) { const int t = tb + k * tstride; if (t < t1) {
            float s = sp[k]; s += __shfl_xor(s, 1); s += __shfl_xor(s, 2); s += __shfl_xor(s, 4); s += __shfl_xor(s, 8); s = __shfl(s, 0);
            const float r = rsqrtf(s * (1.0f / 1024.0f) + 1e-6f); float* yr = p.out + (size_t)t * DM;
#pragma unroll
            for (int i = 0; i < 4; ++i) { const float4 x = xv[k][i]; const u32x2 ow = ov[k][i]; const float4 o = make_float4(__uint_as_float(ow.x << 16), __uint_as_float(ow.x & 0xffff0000u), __uint_as_float(ow.y << 16), __uint_as_float(ow.y & 0xffff0000u));
                *(float4*)(yr + i * 256 + lane * 4) = make_float4(x.x + o.x * r * w[i].x, x.y + o.y * r * w[i].y, x.z + o.z * r * w[i].z, x.w + o.w * r * w[i].w); } } }
#pragma unroll
        for (int k = 0; k < 2; ++k) { sp[k] = ns[k];
#pragma unroll
            for (int i = 0; i < 4; ++i) { xv[k][i] = nx[k][i]; ov[k][i] = no[k][i]; } }
    }
#undef PR_LOAD
}

__device__ __forceinline__ void grid_bar(unsigned* word, unsigned G) {
    asm volatile("s_waitcnt vmcnt(0) lgkmcnt(0)" ::: "memory");
    __syncthreads();
    if (threadIdx.x == 0) {
        __builtin_amdgcn_fence(__ATOMIC_RELEASE, "agent");
        asm volatile("s_waitcnt vmcnt(0)" ::: "memory");
        __hip_atomic_fetch_add(word, 1u, __ATOMIC_RELAXED, __HIP_MEMORY_SCOPE_AGENT);
        while (__hip_atomic_load(word, __ATOMIC_RELAXED, __HIP_MEMORY_SCOPE_AGENT) < G) __builtin_amdgcn_s_sleep(4);
        __builtin_amdgcn_fence(__ATOMIC_ACQUIRE, "agent");
        asm volatile("s_waitcnt vmcnt(0)" ::: "memory");
    }
    __syncthreads();
}

__global__ void __launch_bounds__(NTHR, 2) mega_fwd(Params p) {
    extern __shared__ __attribute__((aligned(16))) unsigned char lds[];
    cg::grid_group grid = cg::this_grid();
    const int tid = threadIdx.x, lane = tid & 63, wave = tid >> 6;
    const int G = gridDim.x, bid = blockIdx.x;
    const int lo = p.ph_lo, hi = p.ph_hi;
#define IN(k) (lo <= (k) && (k) < hi)
#define SEAM(k) do { if (IN(k) && IN((k) + 1)) grid_bar((unsigned*)(p.ws + W_BAR) + 32 * (k), (unsigned)G); } while (0)
    grid.sync();
    PG8_LAS unsigned char* glds = (PG8_LAS unsigned char*)lds;
    const bf16_t* Hn = (const bf16_t*)p.out;
    if (IN(0)) p0_prologue(p, lds);
    SEAM(0);
    if (IN(1)) { __syncthreads();
        pg8::Gemm g{Hn, (const bf16_t*)(p.ws + W_WIN), TT, NIN, 1024}; pg8::StaticOrder S; S.init(TT, NIN, G, bid);
        EpiInProj E{p.ws, p.dt_bias}; pg8::gemm_phase<EpiInProj, pg8::StaticOrder>(glds, g, S, E, nullptr); }
    SEAM(1);
    if (IN(2)) conv_prepass(p, (unsigned*)(p.ws + W_BAR) + 16, G);
    SEAM(2);
    if (IN(3)) {
        const int x = bid & 7, kq = bid >> 3;
        const bool std_grid = (G == 256);
        if (std_grid) {
#pragma unroll 1
            for (int k = 0; k < 3; ++k) { const int is_s = k > 0 ? 1 : 0, su = bid * 2 + (k - 1); ssd_seq(p, lds, is_s, is_s ? su >> 5 : x, is_s ? su & 31 : kq); }
            attn_run(p, lds, x, kq & 3, (kq >> 2) * 16);
            if (bid < 64) attn_unit(p, lds, 1, bid >> 2, 0, bid & 3);
        }
    }
    SEAM(3);
    if (IN(4)) {
        bf16_t* Z = (bf16_t*)(p.ws + W_Z); const float* SSQG = (const float*)(p.ws + W_SSQG);
        const size_t nit = (size_t)TT * 256, gs = (size_t)G * NTHR;
        for (size_t i0 = (size_t)bid * NTHR + tid; i0 < nit; i0 += 4 * gs) {
            u32x4 zv[4]; f32x4 s0[4], s1[4];
#pragma unroll
            for (int k = 0; k < 4; ++k) { const size_t i = i0 + k * gs; const size_t ii = i < nit ? i : i0; const size_t t = ii >> 8; const int c8 = (int)(ii & 255);
                s0[k] = *(const f32x4*)(SSQG + t * 32 + (c8 >> 6) * 8); s1[k] = *(const f32x4*)(SSQG + t * 32 + (c8 >> 6) * 8 + 4); zv[k] = *(const u32x4*)(Z + t * 2048 + c8 * 8); }
#pragma unroll
            for (int k = 0; k < 4; ++k) { const size_t i = i0 + k * gs; if (i < nit) { const size_t t = i >> 8; const int c8 = (int)(i & 255);
                const float r = rsqrtf((((s0[k][0] + s0[k][1]) + (s0[k][2] + s0[k][3])) + ((s1[k][0] + s1[k][1]) + (s1[k][2] + s1[k][3]))) * (1.0f / 512.0f) + 1e-6f);
                float v[8]; unpack8(zv[k], v);
#pragma unroll
                for (int e = 0; e < 8; ++e) v[e] *= r;
                *(u32x4*)(Z + t * 2048 + c8 * 8) = pack8(v); } }
        }
    }
    SEAM(4);
    bf16_t* GA = (bf16_t*)(p.ws + W_GA); bf16_t* GS = (bf16_t*)(p.ws + W_GS); bf16_t* MG = (bf16_t*)(p.ws + W_MG);
#define MERGE_CHAIN(SCHED, S) do { \
        { pg8::Gemm g{Hn, (const bf16_t*)(p.ws + W_WG), TT, 1024, 1024}; EpiMerge<0> E{GA, nullptr}; pg8::gemm_phase<EpiMerge<0>, SCHED>(glds, g, S, E, nullptr); } \
        { pg8::Gemm g{Hn, (const bf16_t*)(p.ws + W_WG) + (size_t)1024 * 1024, TT, 1024, 1024}; EpiMerge<0> E{GS, nullptr}; pg8::gemm_phase<EpiMerge<0>, SCHED>(glds, g, S, E, nullptr); } \
        { pg8::Gemm g{(const bf16_t*)(p.ws + W_Q), (const bf16_t*)(p.ws + W_WAO), TT, 1024, 1024}; EpiMerge<1> E{MG, GA}; pg8::gemm_phase<EpiMerge<1>, SCHED>(glds, g, S, E, nullptr); } \
        { pg8::Gemm g{(const bf16_t*)(p.ws + W_Z), (const bf16_t*)(p.ws + W_WSO), TT, 1024, 2048}; EpiMerge<2> E{MG, GS}; pg8::gemm_phase<EpiMerge<2>, SCHED>(glds, g, S, E, nullptr); } } while (0)
#define OUT_GEMM(SCHED, S) do { pg8::Gemm g{(const bf16_t*)(p.ws + W_MG), (const bf16_t*)(p.ws + W_WOUT), TT, 1024, 1024}; \
        EpiOut E{(bf16_t*)(p.ws + W_Z), (float*)(p.ws + W_SSQO)}; pg8::gemm_phase<EpiOut, SCHED>(glds, g, S, E, nullptr); } while (0)
    if (IN(5)) { __syncthreads(); const TileOrder S{1024, G, bid}; MERGE_CHAIN(TileOrder, S); }
    SEAM(5);
    if (IN(6)) { __syncthreads();
        if (bid < 8) { const SampleOrder S{bid};
            { pg8::Gemm g{Hn, (const bf16_t*)(p.ws + W_WG), TT, 1024, 1024}; EpiMerge<0> E{GA, nullptr}; pg8::gemm_phase<EpiMerge<0>, SampleOrder>(glds, g, S, E, nullptr); }
            { pg8::Gemm g{(const bf16_t*)(p.ws + W_Q), (const bf16_t*)(p.ws + W_WAO), TT, 1024, 1024}; EpiMerge<1> E{MG, GA}; pg8::gemm_phase<EpiMerge<1>, SampleOrder>(glds, g, S, E, nullptr); } }
        else if (bid < 16) { const SampleOrder S{bid - 8};
            { pg8::Gemm g{Hn, (const bf16_t*)(p.ws + W_WG) + (size_t)1024 * 1024, TT, 1024, 1024}; EpiMerge<0> E{GS, nullptr}; pg8::gemm_phase<EpiMerge<0>, SampleOrder>(glds, g, S, E, nullptr); }
            { pg8::Gemm g{(const bf16_t*)(p.ws + W_Z), (const bf16_t*)(p.ws + W_WSO), TT, 1024, 2048}; EpiMerge<1> E{GS, GS}; pg8::gemm_phase<EpiMerge<1>, SampleOrder>(glds, g, S, E, nullptr); } }
        else { const TileOrder S{1024, G - 16, bid - 16}; OUT_GEMM(TileOrder, S); } }
    SEAM(6);
    if (IN(7)) {
        if (bid < 8) { __syncthreads(); const SampleOrder S{bid}; OUT_GEMM(SampleOrder, S);
            { pg8::Gemm g{(const bf16_t*)(p.ws + W_GS), (const bf16_t*)(p.ws + W_WOUT), TT, 1024, 1024}; EpiOutT<1> E{(bf16_t*)(p.ws + W_Z), (float*)(p.ws + W_SSQO)}; pg8::gemm_phase<EpiOutT<1>, SampleOrder>(glds, g, S, E, nullptr); } }
        else post_rows(p, (bid - 8) * 8 + wave, TP, (G - 8) * 8, lane); }
    if (IN(7) && bid < 8) { grid_bar((unsigned*)(p.ws + W_BAR) + 20, 8u); post_rows(p, TP + bid * 8 + wave, TT, 8 * 8, lane); }
#undef IN
#undef SEAM
}

extern "C" void kernel_launch(void* const* d_in, const int* in_sizes, int n_in, void* d_out, int out_size, void* d_ws, size_t ws_size, hipStream_t stream) {
    static int grid = 0;
    if (grid == 0) {
        int dev = 0, cus = 0, per_cu = 0;
        (void)hipGetDevice(&dev); (void)hipDeviceGetAttribute(&cus, hipDeviceAttributeMultiprocessorCount, dev);
        (void)hipFuncSetAttribute((const void*)mega_fwd, hipFuncAttributeMaxDynamicSharedMemorySize, LDS_BYTES);
        (void)hipOccupancyMaxActiveBlocksPerMultiprocessor(&per_cu, (const void*)mega_fwd, NTHR, LDS_BYTES);
        if (per_cu < 1) { fprintf(stderr, "kernel_launch: occupancy query says %d blocks per CU\n", per_cu); per_cu = 1; }
        (void)hipGetLastError();
        grid = cus > 0 ? cus : 256;
        if (ws_size < W_END) fprintf(stderr, "kernel_launch: workspace too small: %zu < %zu\n", ws_size, (size_t)W_END);
    }
    Params p{};
    const float** pp = (const float**)&p;
    for (int i = 0; i < 19; ++i) pp[i] = (const float*)d_in[i];
    p.out = (float*)d_out; p.ws = (unsigned char*)d_ws; p.ph_lo = 0; p.ph_hi = 9; p.dbg = 0; p.ws_size = (unsigned long long)ws_size;
    (void)hipMemsetAsync((unsigned char*)d_ws + W_BAR, 0, 1024, stream);
    void* args[] = {&p};
    hipError_t e = hipLaunchCooperativeKernel((const void*)mega_fwd, dim3(grid), dim3(NTHR), args, LDS_BYTES, stream);
    if (e != hipSuccess) fprintf(stderr, "cooperative launch failed: %s (grid %d)\n", hipGetErrorString(e), grid);
}
```

```cpp
#include <hip/hip_runtime.h>
#include <hip/hip_cooperative_groups.h>
#include <cstdio>
namespace pg8 {
#define PG8_LAS __attribute__((address_space(3)))
typedef unsigned short bf16_t;
typedef short bf16x8 __attribute__((ext_vector_type(8)));
typedef float f32x4 __attribute__((ext_vector_type(4)));
typedef unsigned u32x4 __attribute__((ext_vector_type(4)));
constexpr int BM = 256, BK = 64, HALF = 128, HTB = HALF * BK * 2  , STAGE_BYTES = 8 * HTB, NXCD = 8, WGM = 8;

__host__ __device__ __forceinline__ int lds_byte(int r, int c) { const int st = (r >> 4) * 2 + (c >> 5), rr = r & 15, cc = c & 31, ob = rr * 64 + cc * 2; return st * 1024 + (ob ^ (((ob >> 9) & 1) << 5)); }
__host__ __device__ __forceinline__ void stage_rc(int b, int& R, int& C) { const int st = b / 1024, sb = b % 1024, swz = sb ^ (((sb >> 9) & 1) << 5); R = (st >> 1) * 16 + swz / 64; C = (st & 1) * 32 + (swz % 64) / 2; }
__host__ __device__ __forceinline__ int perm32(int rho) { const int n = rho >> 4, i = rho & 15; return 8 * (i >> 2) + 4 * n + (i & 3); }

struct Unit { int pm, pn; };
struct Gemm { const bf16_t* A; const bf16_t* Bt; int M, N, K; };

struct StaticOrder {
    int nM, nN, nwg, G, c;
    __host__ __device__ void init(int M, int N, int G_, int c_) { nM = M / BM; nN = N / BM; nwg = nM * nN; G = G_; c = c_; }
    __host__ __device__ bool next(int i, Unit& u) const {
        const long L = (long)i * G + c; if (L >= nwg) return false;
        int wgid = (int)L; { const int q = nwg / NXCD, r = nwg % NXCD, xcd = wgid % NXCD, off = wgid / NXCD; wgid = (xcd < r ? xcd * (q + 1) : r * (q + 1) + (xcd - r) * q) + off; }
        const int nig = WGM * nN, gid = wgid / nig, fm = gid * WGM, gsz = (nM - fm) < WGM ? (nM - fm) : WGM;
        u.pm = fm + ((wgid % nig) % gsz); u.pn = (wgid % nig) / gsz; return true;
    }
    __device__ __forceinline__ void a_ready(const Unit&) const {}
    __device__ __forceinline__ void done(const Unit&) const {}
};
typedef __bf16 bf16n2 __attribute__((ext_vector_type(2))); typedef float f32n2 __attribute__((ext_vector_type(2)));
__device__ __forceinline__ unsigned cvt_pk_bf16(float lo, float hi) { f32n2 v = {lo, hi}; return __builtin_bit_cast(unsigned, __builtin_convertvector(v, bf16n2)); }
typedef float f32x2 __attribute__((ext_vector_type(2)));
template <class Epi, class Sched, bool STAMP = false>
__device__ __forceinline__ void gemm_phase(PG8_LAS unsigned char* lds, const Gemm g, const Sched& S, const Epi& E, unsigned long long* stamps) {
    const int tid = threadIdx.x, wid = __builtin_amdgcn_readfirstlane(tid >> 6), lane = tid & 63, wr = wid >> 2, wc = wid & 3, fr = lane & 15, fq = lane >> 4;
    const int K = g.K, nt = K / BK;
    int ts_lo = 0, ts_hi = 0, nts = 0; const unsigned long long rt_entry = STAMP ? (unsigned long long)wall_clock64() : 0ull;
#define PG8_STAMP() do { if (STAMP && wid == 0 && nts < 64) { const unsigned long long _c = (unsigned long long)clock64(); \
        ts_lo = (lane == nts) ? (int)(unsigned)_c : ts_lo; ts_hi = (lane == nts) ? (int)(unsigned)(_c >> 32) : ts_hi; ++nts; } } while (0)
    PG8_STAMP();
    unsigned voffA[2], voffB[2];
#pragma unroll
    for (int i = 0; i < 2; ++i) { int R, C; stage_rc(tid * 16 + i * 8192, R, C); const int Rb = Epi::PERM ? ((R & ~31) + perm32(R & 31)) : R;
        voffA[i] = (unsigned)(R * K + C) * 2u; voffB[i] = (unsigned)(Rb * K + C) * 2u; }
    const size_t kstep = (size_t)(BK * 2);
    const size_t hstep = (size_t)HALF * K * 2;
    const size_t tstep = 2 * hstep;
    const unsigned ldsw = (unsigned)wid * 1024u;
    const int aoff = lds_byte(wr * 64 + fr, fq * 8), boff = lds_byte(wc * 32 + fr, fq * 8);
#define PG8_SA(b, h) (((b) * 2 + (h)) * HTB)
#define PG8_SB(b, h) ((4 + (b) * 2 + (h)) * HTB)
#define PG8_STAGE(bufoff, gbase, voff) do { _Pragma("unroll") for (int _i = 0; _i < 2; ++_i) \
        __builtin_amdgcn_global_load_lds((const unsigned*)((const char*)(gbase) + (voff)[_i]), (PG8_LAS unsigned*)(lds + (bufoff) + ldsw + _i * 8192), 16, 0, 0); } while (0)
#define PG8_LDA(dst, b, h) do { _Pragma("unroll") for (int m = 0; m < 4; ++m) _Pragma("unroll") for (int k = 0; k < 2; ++k) dst[m][k] = *(const PG8_LAS bf16x8*)(lds + PG8_SA(b, h) + aoff + m * 2048 + k * 1024); } while (0)
#define PG8_LDB(dst, b, h) do { _Pragma("unroll") for (int n = 0; n < 2; ++n) _Pragma("unroll") for (int k = 0; k < 2; ++k) dst[n][k] = *(const PG8_LAS bf16x8*)(lds + PG8_SB(b, h) + boff + n * 2048 + k * 1024); } while (0)
#define PG8_MMA(ai, bj, At, Bt) do { __builtin_amdgcn_s_setprio(1); _Pragma("unroll") for (int m = 0; m < 4; ++m) _Pragma("unroll") for (int n = 0; n < 2; ++n) _Pragma("unroll") for (int k = 0; k < 2; ++k) \
        acc[ai][bj][m][n] = __builtin_amdgcn_mfma_f32_16x16x32_bf16(Bt[n][k], At[m][k], acc[ai][bj][m][n], 0, 0, 0); __builtin_amdgcn_s_setprio(0); } while (0)
#define PG8_WAIT_V(n) asm volatile("s_waitcnt vmcnt(" #n ")" ::: "memory")
#define PG8_WAIT_L(n) asm volatile("s_waitcnt lgkmcnt(" #n ")" ::: "memory")
#define PG8_BAR __builtin_amdgcn_s_barrier()
#define PG8_SCHED __builtin_amdgcn_sched_barrier(0)
    Unit cur, nxt; int ui = 0;
    if (!S.next(0, cur)) return;
    f32x4 acc[2][2][4][2];
#pragma unroll
    for (int a = 0; a < 2; ++a)
#pragma unroll
        for (int b = 0; b < 2; ++b)
#pragma unroll
            for (int m = 0; m < 4; ++m)
#pragma unroll
                for (int n = 0; n < 2; ++n) acc[a][b][m][n] = (f32x4){0.f, 0.f, 0.f, 0.f};
    bf16x8 At[4][2], B0[2][2], B1[2][2];
    const char* cA = (const char*)g.A + (size_t)cur.pm * tstep; const char* cB = (const char*)g.Bt + (size_t)cur.pn * tstep;
    S.a_ready(cur);
    PG8_STAGE(PG8_SB(0, 0), cB, voffB); PG8_STAGE(PG8_SA(0, 0), cA, voffA); PG8_STAGE(PG8_SB(0, 1), cB + hstep, voffB); PG8_STAGE(PG8_SA(0, 1), cA + hstep, voffA);
    if (wr == 1) PG8_BAR;
    PG8_WAIT_V(4); PG8_BAR;
    PG8_STAGE(PG8_SB(1, 0), cB + kstep, voffB); PG8_STAGE(PG8_SA(1, 0), cA + kstep, voffA); PG8_STAGE(PG8_SB(1, 1), cB + hstep + kstep, voffB);
    PG8_WAIT_V(6); PG8_BAR;
    PG8_STAMP();
    for (;;) {
        const bool has_next = S.next(ui + 1, nxt);
        const char* nA = has_next ? (const char*)g.A + (size_t)nxt.pm * tstep : cA; const char* nB = has_next ? (const char*)g.Bt + (size_t)nxt.pn * tstep : cB;
        for (int t = 0; t < nt; t += 2) {
            const bool last = (t == nt - 2);
            const char* a1 = cA + (size_t)(t + 1) * kstep;
            const char* a2 = last ? nA : cA + (size_t)(t + 2) * kstep; const char* b2 = last ? nB : cB + (size_t)(t + 2) * kstep;
            const char* a3 = a2 + kstep; const char* b3 = b2 + kstep;
            if (last && has_next) S.a_ready(nxt);
            PG8_LDB(B0, 0, 0); PG8_SCHED; PG8_LDA(At, 0, 0); PG8_STAGE(PG8_SA(1, 1), a1 + hstep, voffA);
            PG8_WAIT_L(8); PG8_BAR; PG8_WAIT_L(0); PG8_MMA(0, 0, At, B0); PG8_BAR; PG8_SCHED;
            PG8_LDB(B1, 0, 1); PG8_STAGE(PG8_SB(0, 0), b2, voffB);
            PG8_BAR; PG8_WAIT_L(0); PG8_MMA(0, 1, At, B1); PG8_BAR;
            PG8_LDA(At, 0, 1); PG8_STAGE(PG8_SA(0, 0), a2, voffA);
            PG8_BAR; PG8_WAIT_L(0); PG8_MMA(1, 0, At, B0); PG8_BAR; PG8_SCHED;
            PG8_STAGE(PG8_SB(0, 1), b2 + hstep, voffB);
            PG8_WAIT_V(6); PG8_BAR; PG8_MMA(1, 1, At, B1); PG8_BAR;
            PG8_LDB(B0, 1, 0); PG8_SCHED; PG8_LDA(At, 1, 0); PG8_STAGE(PG8_SA(0, 1), a2 + hstep, voffA);
            PG8_WAIT_L(8); PG8_BAR; PG8_WAIT_L(0); PG8_MMA(0, 0, At, B0); PG8_BAR; PG8_SCHED;
            PG8_LDB(B1, 1, 1); PG8_STAGE(PG8_SB(1, 0), b3, voffB);
            PG8_BAR; PG8_WAIT_L(0); PG8_MMA(0, 1, At, B1); PG8_BAR;
            PG8_LDA(At, 1, 1); PG8_STAGE(PG8_SA(1, 0), a3, voffA);
            PG8_BAR; PG8_WAIT_L(0); PG8_MMA(1, 0, At, B0); PG8_BAR; PG8_SCHED;
            PG8_STAGE(PG8_SB(1, 1), b3 + hstep, voffB);
            PG8_WAIT_V(6); PG8_BAR; PG8_MMA(1, 1, At, B1); PG8_BAR;
        }
        PG8_STAMP();
        if constexpr (!Epi::AFTER_DRAIN) { E(acc, cur, wr, wc, fr, fq); S.done(cur); }
        PG8_STAMP();
        if (!has_next) break;
#pragma unroll
        for (int a = 0; a < 2; ++a)
#pragma unroll
            for (int b = 0; b < 2; ++b)
#pragma unroll
                for (int m = 0; m < 4; ++m)
#pragma unroll
                    for (int n = 0; n < 2; ++n) acc[a][b][m][n] = (f32x4){0.f, 0.f, 0.f, 0.f};
        cur = nxt; cA = nA; cB = nB; ++ui;
    }
    PG8_WAIT_V(0);
    if (wr == 0) PG8_BAR;
    PG8_BAR;
    if constexpr (Epi::AFTER_DRAIN) { E.fused(acc, cur, wr, wc, fr, fq, lds, wid, lane); S.done(cur); }
    PG8_STAMP();
    if (STAMP && wid == 0) { stamps[lane] = lane < nts ? (((unsigned long long)(unsigned)ts_hi << 32) | (unsigned)ts_lo) : 0ull;
        if (lane == 62) stamps[62] = rt_entry; if (lane == 63) stamps[63] = (unsigned long long)wall_clock64(); }
#undef PG8_STAMP
#undef PG8_SA
#undef PG8_SB
#undef PG8_STAGE
#undef PG8_LDA
#undef PG8_LDB
#undef PG8_MMA
#undef PG8_WAIT_V
#undef PG8_WAIT_L
#undef PG8_BAR
#undef PG8_SCHED
}
}

namespace cg = cooperative_groups;
typedef unsigned short bf16_t;
typedef short bf16x8 __attribute__((ext_vector_type(8)));
typedef short bf16x4 __attribute__((ext_vector_type(4)));
typedef float f32x4 __attribute__((ext_vector_type(4)));
typedef unsigned u32x4 __attribute__((ext_vector_type(4)));
typedef unsigned u32x2 __attribute__((ext_vector_type(2)));

constexpr int TP = 65536, TS = 512, TT = TP + TS;
constexpr int DM = 1024;
constexpr int NTHR = 512;
constexpr int LDS_BYTES = 131072;
constexpr int NIN = 7936;
constexpr int IN_W = 9760;

constexpr size_t O_YP = 0, O_YS = 67108864, O_KP = 67633152, O_VP = 67895296, O_CP = 68157440, O_SP = 68231168,
                 O_KS = 70328320, O_VS = 70459392, O_CS = 70590464, O_SS = 70737920;
constexpr size_t SZ1K = (size_t)TT * 1024 * 2;
constexpr size_t W_Q = 0, W_K = W_Q + SZ1K, W_V = W_K + SZ1K / 4, W_G = W_V + SZ1K / 4, W_Z = W_G + SZ1K, W_XBC = W_Z + 2 * SZ1K,
                 W_DT = W_XBC + 3 * SZ1K, W_WIN = W_DT + (size_t)TT * 32 * 4, W_WG = W_WIN + (size_t)NIN * 1024 * 2, W_WAO = W_WG + 2048 * 1024 * 2,
                 W_WSO = W_WAO + 1024 * 1024 * 2, W_WOUT = W_WSO + 1024 * 2048 * 2, W_ROPE = W_WOUT + 1024 * 1024 * 2,
                 W_SSQG = W_ROPE + 8224 * 8 * 8, W_SSQO = W_SSQG + (size_t)TT * 32 * 4, W_BAR = W_SSQO + (size_t)TT * 16 * 4, W_END = W_BAR + 1024;
constexpr size_t W_GA = W_XBC, W_GS = W_XBC + SZ1K, W_MG = W_XBC + 2 * SZ1K;
static_assert(W_END <= (size_t)1073741824, "workspace");

struct Params {
    const float *x_prompt, *x_sample, *cache_k, *cache_v, *state_conv, *state_ssm, *pre_norm_w, *w_in, *conv_w, *conv_b, *dt_bias, *a_log, *d_skip,
        *sinks, *ssm_norm_w, *w_attn_o, *w_ssm_o, *w_out, *post_norm_w;
    float* out; unsigned char* ws; int ph_lo, ph_hi; unsigned long long ws_size; int dbg, pad;
};

__device__ __forceinline__ unsigned short f2bf(float f) { unsigned u = __float_as_uint(f); u += 0x7FFFu + ((u >> 16) & 1u); return (unsigned short)(u >> 16); }
__device__ __forceinline__ float bf2f(unsigned short b) { return __uint_as_float(((unsigned)b) << 16); }
__device__ __forceinline__ float bf2f_s(short b) { return __uint_as_float(((unsigned)(unsigned short)b) << 16); }
__device__ __forceinline__ unsigned pk2(float lo, float hi) { return pg8::cvt_pk_bf16(lo, hi); }
__device__ __forceinline__ float sigmoidf_(float x) { return __builtin_amdgcn_rcpf(1.0f + __expf(-x)); }
__device__ __forceinline__ float siluf_(float x) { return x * __builtin_amdgcn_rcpf(1.0f + __expf(-x)); }
__device__ __forceinline__ void unpack8(const u32x4 w, float (&v)[8]) {
    v[0] = __uint_as_float(w.x << 16); v[1] = __uint_as_float(w.x & 0xffff0000u); v[2] = __uint_as_float(w.y << 16); v[3] = __uint_as_float(w.y & 0xffff0000u);
    v[4] = __uint_as_float(w.z << 16); v[5] = __uint_as_float(w.z & 0xffff0000u); v[6] = __uint_as_float(w.w << 16); v[7] = __uint_as_float(w.w & 0xffff0000u);
}
__device__ __forceinline__ u32x4 pack8(const float (&v)[8]) { u32x4 w; w.x = pk2(v[0], v[1]); w.y = pk2(v[2], v[3]); w.z = pk2(v[4], v[5]); w.w = pk2(v[6], v[7]); return w; }

__device__ __forceinline__ void transpose_tile(unsigned char* lds, const float* src, int ld, int col0, int ncols_valid, int k0, bf16_t* dst, int dstK, int n0, const float* kscale) {
    float* tile = (float*)lds;
    const int tid = threadIdx.x;
    const int kk = tid >> 4, c4 = (tid & 15) * 4;
#pragma unroll
    for (int pass = 0; pass < 2; ++pass) {
        const int k = kk + pass * 32;
        float4 v = make_float4(0.f, 0.f, 0.f, 0.f);
        if (c4 < ncols_valid) v = *(const float4*)(src + (size_t)(k0 + k) * ld + col0 + c4);
        if (kscale) { const float s = kscale[k0 + k]; v.x *= s; v.y *= s; v.z *= s; v.w *= s; }
        tile[k * 65 + c4 + 0] = v.x; tile[k * 65 + c4 + 1] = v.y; tile[k * 65 + c4 + 2] = v.z; tile[k * 65 + c4 + 3] = v.w;
    }
    __syncthreads();
    const int n = tid >> 3, kg = tid & 7;
    float v[8];
#pragma unroll
    for (int j = 0; j < 8; ++j) v[j] = tile[(kg * 8 + j) * 65 + n];
    *(u32x4*)(dst + (size_t)(n0 + n) * dstK + k0 + kg * 8) = pack8(v);
    __syncthreads();
}

__device__ __forceinline__ void p0_prologue(const Params& p, unsigned char* lds) {
    const int tid = threadIdx.x, lane = tid & 63, wave = tid >> 6;
    const int G = gridDim.x, bid = blockIdx.x;
    bf16_t* H = (bf16_t*)p.out;
    { float4 wv[4];
#pragma unroll
      for (int i = 0; i < 4; ++i) wv[i] = *(const float4*)(p.pre_norm_w + i * 256 + lane * 4);
      float4 v[2][4], nv[2][4];
      const int tstep = 2 * G * 8;
#define P0_LOAD(dst, tb_) do { _Pragma("unroll") for (int k = 0; k < 2; ++k) { const int t_ = (tb_) + k * G * 8; const int tt_ = t_ < TT ? t_ : TT - 1; \
          const float* xr_ = tt_ < TP ? p.x_prompt + (size_t)tt_ * DM : p.x_sample + (size_t)(tt_ - TP) * DM; \
          _Pragma("unroll") for (int i = 0; i < 4; ++i) dst[k][i] = *(const float4*)(xr_ + i * 256 + lane * 4); } } while (0)
      int tb = bid * 8 + wave;
      if (tb < TT) P0_LOAD(v, tb);
      for (; tb < TT; tb += tstep) {
        if (tb + tstep < TT) P0_LOAD(nv, tb + tstep);
#pragma unroll
        for (int k = 0; k < 2; ++k) { const int t = tb + k * G * 8; if (t < TT) {
            float ss = 0.f;
#pragma unroll
            for (int i = 0; i < 4; ++i) ss += v[k][i].x * v[k][i].x + v[k][i].y * v[k][i].y + v[k][i].z * v[k][i].z + v[k][i].w * v[k][i].w;
#pragma unroll
            for (int o = 32; o >= 1; o >>= 1) ss += __shfl_xor(ss, o);
            const float r = rsqrtf(ss * (1.0f / 1024.0f) + 1e-6f);
#pragma unroll
            for (int i = 0; i < 4; ++i) { u32x2 o; o.x = pk2(v[k][i].x * r * wv[i].x, v[k][i].y * r * wv[i].y); o.y = pk2(v[k][i].z * r * wv[i].z, v[k][i].w * r * wv[i].w);
                *(u32x2*)(H + (size_t)t * DM + i * 256 + lane * 4) = o; } } }
#pragma unroll
        for (int k = 0; k < 2; ++k)
#pragma unroll
            for (int i = 0; i < 4; ++i) v[k][i] = nv[k][i];
      }
#undef P0_LOAD
    }
    bf16_t* WIN = (bf16_t*)(p.ws + W_WIN); bf16_t* WG = (bf16_t*)(p.ws + W_WG); bf16_t* WAO = (bf16_t*)(p.ws + W_WAO);
    bf16_t* WSO = (bf16_t*)(p.ws + W_WSO); bf16_t* WOUT = (bf16_t*)(p.ws + W_WOUT);
    constexpr int J0 = 1920, J1 = J0 + 16, J2 = J1 + 512, J3 = J2 + 256, J4 = J3 + 512, J5 = J4 + 256;
    {
        float* tile = (float*)lds;
        const int kk = tid >> 4, c4 = (tid & 15) * 4, tn = tid >> 3, tkg = tid & 7;
        const float* src = nullptr; int ld = 0, col0 = 0, valid = 0, k0 = 0, dstK = 0, n0 = 0; bf16_t* dst = nullptr; const float* kscale = nullptr;
#define TJ_DECODE(j) do { \
        if ((j) < J0) { const int nt = (j) >> 4, kt = (j) & 15; src = p.w_in; ld = IN_W; col0 = nt * 64; valid = 64; k0 = kt * 64; dst = WIN; dstK = 1024; n0 = nt * 64; kscale = nullptr; } \
        else if ((j) < J1) { const int kt = (j) - J0; src = p.w_in; ld = IN_W; col0 = 7680; valid = 32; k0 = kt * 64; dst = WIN; dstK = 1024; n0 = 7680; kscale = nullptr; } \
        else if ((j) < J2) { const int jj = (j) - J1, nt = jj >> 4, kt = jj & 15; src = p.w_in; ld = IN_W; col0 = 7712 + nt * 64; valid = 64; k0 = kt * 64; dst = WG; dstK = 1024; n0 = nt * 64; kscale = nullptr; } \
        else if ((j) < J3) { const int jj = (j) - J2, nt = jj >> 4, kt = jj & 15; src = p.w_attn_o; ld = 1024; col0 = nt * 64; valid = 64; k0 = kt * 64; dst = WAO; dstK = 1024; n0 = nt * 64; kscale = nullptr; } \
        else if ((j) < J4) { const int jj = (j) - J3, nt = jj >> 5, kt = jj & 31; src = p.w_ssm_o; ld = 1024; col0 = nt * 64; valid = 64; k0 = kt * 64; dst = WSO; dstK = 2048; n0 = nt * 64; kscale = p.ssm_norm_w; } \
        else { const int jj = (j) - J4, nt = jj >> 4, kt = jj & 15; src = p.w_out; ld = 1024; col0 = nt * 64; valid = 64; k0 = kt * 64; dst = WOUT; dstK = 1024; n0 = nt * 64; kscale = nullptr; } } while (0)
#define TJ_LOAD() do { _Pragma("unroll") for (int ps = 0; ps < 2; ++ps) { const int k = kk + ps * 32; float4 v_ = make_float4(0.f, 0.f, 0.f, 0.f); \
            if (c4 < valid) v_ = *(const float4*)(src + (size_t)(k0 + k) * ld + col0 + c4); \
            if (kscale) { const float s_ = kscale[k0 + k]; v_.x *= s_; v_.y *= s_; v_.z *= s_; v_.w *= s_; } tv[ps] = v_; } } while (0)
        float4 tv[2];
        int j = bid;
        if (j < J5) { TJ_DECODE(j); TJ_LOAD(); }
        for (; j < J5; j += G) {
#pragma unroll
            for (int ps = 0; ps < 2; ++ps) { const int k = kk + ps * 32; tile[k * 65 + c4 + 0] = tv[ps].x; tile[k * 65 + c4 + 1] = tv[ps].y; tile[k * 65 + c4 + 2] = tv[ps].z; tile[k * 65 + c4 + 3] = tv[ps].w; }
            __syncthreads();
            bf16_t* const dptr = dst + (size_t)(n0 + tn) * dstK + k0 + tkg * 8;
            if (j + G < J5) { TJ_DECODE(j + G); TJ_LOAD(); }
            float v[8];
#pragma unroll
            for (int e = 0; e < 8; ++e) v[e] = tile[(tkg * 8 + e) * 65 + tn];
            *(u32x4*)dptr = pack8(v);
            __syncthreads();
        }
#undef TJ_DECODE
#undef TJ_LOAD
    }
    const size_t gtid = (size_t)bid * NTHR + tid, gstride = (size_t)G * NTHR;
    { u32x4* z = (u32x4*)(WIN + (size_t)7744 * 1024); const size_t n16 = (size_t)192 * 1024 * 2 / 16; const u32x4 zero = {0u, 0u, 0u, 0u};
      for (size_t i = gtid; i < n16; i += gstride) z[i] = zero; }
    { float2* rope = (float2*)(p.ws + W_ROPE);
      for (size_t i = gtid; i < 8224 * 8; i += gstride) { const int pi = (int)(i >> 3), j = (int)(i & 7); const int pos = pi < 8192 ? pi : 2048 + (pi - 8192);
          const float inv = (float)pow(500000.0, -(double)j / 8.0); const float ang = (float)pos * inv; double s, c; sincos((double)ang, &s, &c); rope[i] = make_float2((float)c, (float)s); } }
}

struct EpiInProj {
    static constexpr bool PERM = true, AFTER_DRAIN = false;
    unsigned char* ws; const float* dt_bias;
    __device__ __forceinline__ void operator()(const f32x4 (&acc)[2][2][4][2], const pg8::Unit& u, int wr, int wc, int fr, int fq) const {
        const int pn = u.pn; const int row0 = u.pm * 256 + wr * 64 + fr;
        if (pn == 30) {
            if (wc == 0) { float* DT = (float*)(ws + W_DT);
#pragma unroll
                for (int n = 0; n < 2; ++n) { const f32x4 bv = *(const f32x4*)(dt_bias + 8 * fq + 4 * n);
#pragma unroll
                    for (int ai = 0; ai < 2; ++ai)
#pragma unroll
                        for (int m = 0; m < 4; ++m) { f32x4 v = acc[ai][0][m][n] + bv;
#pragma unroll
                            for (int j = 0; j < 4; ++j) v[j] = v[j] > 20.f ? v[j] : log1pf(__expf(v[j]));
                            *(f32x4*)(DT + (size_t)(row0 + ai * 128 + m * 16) * 32 + 8 * fq + 4 * n) = v; } } }
            return;
        }
        bf16_t* base; int ldc, colt;
        if (pn < 4) { base = (bf16_t*)(ws + W_Q); ldc = 1024; colt = pn * 256; }
        else if (pn == 4) { base = (bf16_t*)(ws + W_K); ldc = 256; colt = 0; }
        else if (pn == 5) { base = (bf16_t*)(ws + W_V); ldc = 256; colt = 0; }
        else if (pn < 10) { base = (bf16_t*)(ws + W_G); ldc = 1024; colt = (pn - 6) * 256; }
        else if (pn < 18) { base = (bf16_t*)(ws + W_Z); ldc = 2048; colt = (pn - 10) * 256; }
        else { base = (bf16_t*)(ws + W_XBC); ldc = 3072; colt = (pn - 18) * 256; }
        const int col0 = colt + wc * 32 + 8 * fq;
#pragma unroll
        for (int ai = 0; ai < 2; ++ai)
#pragma unroll
            for (int m = 0; m < 4; ++m) { bf16_t* rowp = base + (size_t)(row0 + ai * 128 + m * 16) * ldc + col0;
#pragma unroll
                for (int bj = 0; bj < 2; ++bj) { const f32x4 v0 = acc[ai][bj][m][0], v1 = acc[ai][bj][m][1];
                    u32x4 w; w.x = pk2(v0[0], v0[1]); w.y = pk2(v0[2], v0[3]); w.z = pk2(v1[0], v1[1]); w.w = pk2(v1[2], v1[3]);
                    *(u32x4*)(rowp + bj * 128) = w; } }
    }
};
template <int MODE> struct EpiMerge {
    static constexpr bool PERM = true, AFTER_DRAIN = false;
    bf16_t* O; const bf16_t* G1;
    __device__ __forceinline__ void operator()(const f32x4 (&acc)[2][2][4][2], const pg8::Unit& u, int wr, int wc, int fr, int fq) const {
        const int row0 = u.pm * 256 + wr * 64 + fr; const int col0 = u.pn * 256 + wc * 32 + 8 * fq;
#pragma unroll
        for (int ai = 0; ai < 2; ++ai) {
            u32x4 gq[4][2], oq[4][2];
            if (MODE != 0) {
#pragma unroll
                for (int m = 0; m < 4; ++m)
#pragma unroll
                    for (int bj = 0; bj < 2; ++bj) { const size_t off = (size_t)(row0 + ai * 128 + m * 16) * 1024 + col0 + bj * 128;
                        gq[m][bj] = *(const u32x4*)(G1 + off); if (MODE == 2) oq[m][bj] = *(const u32x4*)(O + off); }
            }
#pragma unroll
            for (int m = 0; m < 4; ++m)
#pragma unroll
                for (int bj = 0; bj < 2; ++bj) { const size_t off = (size_t)(row0 + ai * 128 + m * 16) * 1024 + col0 + bj * 128;
                    const f32x4 v0 = acc[ai][bj][m][0], v1 = acc[ai][bj][m][1];
                    float v[8] = {v0[0], v0[1], v0[2], v0[3], v1[0], v1[1], v1[2], v1[3]};
                    if (MODE == 0) {
#pragma unroll
                        for (int j = 0; j < 8; ++j) v[j] = sigmoidf_(v[j]);
                    } else { float g[8]; unpack8(gq[m][bj], g);
                        if (MODE == 1) {
#pragma unroll
                            for (int j = 0; j < 8; ++j) v[j] = g[j] * v[j];
                        } else { float o[8]; unpack8(oq[m][bj], o);
#pragma unroll
                            for (int j = 0; j < 8; ++j) v[j] = o[j] + g[j] * v[j]; } }
                    *(u32x4*)(O + off) = pack8(v); }
        }
    }
};
template <int ADD> struct EpiOutT {
    static constexpr bool PERM = true, AFTER_DRAIN = false;
    bf16_t* out; float* ssq;
    __device__ __forceinline__ void operator()(const f32x4 (&acc)[2][2][4][2], const pg8::Unit& u, int wr, int wc, int fr, int fq) const {
        const int row0 = u.pm * 256 + wr * 64 + fr, col0 = u.pn * 256 + wc * 32 + 8 * fq;
#pragma unroll
        for (int ai = 0; ai < 2; ++ai)
#pragma unroll
            for (int m = 0; m < 4; ++m) { const int row = row0 + ai * 128 + m * 16; bf16_t* rowp = out + (size_t)row * 1024 + col0;
                float s = 0.f;
#pragma unroll
                for (int bj = 0; bj < 2; ++bj) { const f32x4 v0 = acc[ai][bj][m][0], v1 = acc[ai][bj][m][1];
                    float v[8] = {v0[0], v0[1], v0[2], v0[3], v1[0], v1[1], v1[2], v1[3]};
                    if (ADD) { float o[8]; unpack8(*(const u32x4*)(rowp + bj * 128), o);
#pragma unroll
                        for (int j = 0; j < 8; ++j) v[j] += o[j]; }
#pragma unroll
                    for (int j = 0; j < 8; ++j) s += v[j] * v[j];
                    *(u32x4*)(rowp + bj * 128) = pack8(v); }
                s += __shfl_xor(s, 16); s += __shfl_xor(s, 32);
                if (fq == 0) ssq[(size_t)row * 16 + u.pn * 4 + wc] = s; }
    }
};

constexpr int KS_STRIDE = 72;
constexpr int VT_STRIDE = 200;
constexpr int KS_OFF = 0, VT_OFF = 192 * KS_STRIDE * 2;

__device__ __forceinline__ void attn_unit(const Params& p, unsigned char* lds, const int is_sample, const int b, const int c, const int kvh) {
    const int tid = threadIdx.x, lane = tid & 63, wave = tid >> 6, fr = lane & 15, fq = lane >> 4;
    bf16_t* Q = (bf16_t*)(p.ws + W_Q); const bf16_t* K = (const bf16_t*)(p.ws + W_K); const bf16_t* V = (const bf16_t*)(p.ws + W_V);
    const bf16_t* GT = (const bf16_t*)(p.ws + W_G); const float2* rope = (const float2*)(p.ws + W_ROPE);
    bf16_t* Ks = (bf16_t*)(lds + KS_OFF); bf16_t* Vt = (bf16_t*)(lds + VT_OFF);
    int nkeys, ncache, NQ, cs; size_t tq0, tk0; int pos_q0, pos_k0;
    if (is_sample) { nkeys = 160; ncache = 128; NQ = 32; cs = 0; tq0 = (size_t)TP + b * 32; tk0 = tq0; pos_q0 = 8192; pos_k0 = 8192; }
    else { cs = c >= 2 ? c - 2 : 0; nkeys = (c - cs + 1) * 64; ncache = 0; NQ = 64; tq0 = (size_t)b * 8192 + c * 64; tk0 = (size_t)b * 8192 + cs * 64; pos_q0 = c * 64; pos_k0 = cs * 64; }
    __syncthreads();
    for (int item = tid; item < nkeys * 4; item += NTHR) {
        const int key = item >> 2, i = item & 3;
        float v[16];
        if (key < ncache) { const float* src = p.cache_k + ((size_t)(b * 128 + key) * 4 + kvh) * 64 + i * 16;
#pragma unroll
            for (int q4 = 0; q4 < 4; ++q4) { const float4 f = *(const float4*)(src + q4 * 4); v[q4 * 4] = f.x; v[q4 * 4 + 1] = f.y; v[q4 * 4 + 2] = f.z; v[q4 * 4 + 3] = f.w; }
        } else {
            const int kk = key - ncache; const bf16_t* src = K + (tk0 + kk) * 256 + kvh * 64 + i * 16;
            float a[8], bb[8]; unpack8(*(const u32x4*)src, a); unpack8(*(const u32x4*)(src + 8), bb);
            if (i == 0) { const float2* rp = rope + (size_t)(pos_k0 + kk) * 8;
#pragma unroll
                for (int j = 0; j < 8; ++j) { const float2 cssn = rp[j]; v[j] = a[j] * cssn.x - bb[j] * cssn.y; v[8 + j] = bb[j] * cssn.x + a[j] * cssn.y; }
            } else {
#pragma unroll
                for (int j = 0; j < 8; ++j) { v[j] = a[j]; v[8 + j] = bb[j]; } }
            float* dst = nullptr;
            if (is_sample) dst = p.out + O_KS + ((size_t)(b * 32 + kk) * 4 + kvh) * 64 + i * 16;
            else if (c >= 126 && kk >= (c - cs) * 64) dst = p.out + O_KP + ((size_t)(b * 128 + (c - 126) * 64 + (kk - (c - cs) * 64)) * 4 + kvh) * 64 + i * 16;
            if (dst) {
#pragma unroll
                for (int q4 = 0; q4 < 4; ++q4) *(float4*)(dst + q4 * 4) = make_float4(v[q4 * 4], v[q4 * 4 + 1], v[q4 * 4 + 2], v[q4 * 4 + 3]); }
        }
        float lo[8], hi[8];
#pragma unroll
        for (int j = 0; j < 8; ++j) { lo[j] = v[j]; hi[j] = v[8 + j]; }
        *(u32x4*)(Ks + key * KS_STRIDE + i * 16) = pack8(lo); *(u32x4*)(Ks + key * KS_STRIDE + i * 16 + 8) = pack8(hi);
    }
    for (int item = tid; item < nkeys * 8; item += NTHR) {
        const int dg = item / nkeys, key = item - dg * nkeys;
        float v[8];
        if (key < ncache) { const float* src = p.cache_v + ((size_t)(b * 128 + key) * 4 + kvh) * 64 + dg * 8;
            const float4 f0 = *(const float4*)src, f1 = *(const float4*)(src + 4); v[0] = f0.x; v[1] = f0.y; v[2] = f0.z; v[3] = f0.w; v[4] = f1.x; v[5] = f1.y; v[6] = f1.z; v[7] = f1.w;
        } else {
            const int kk = key - ncache; unpack8(*(const u32x4*)(V + (tk0 + kk) * 256 + kvh * 64 + dg * 8), v);
            float* dst = nullptr;
            if (is_sample) dst = p.out + O_VS + ((size_t)(b * 32 + kk) * 4 + kvh) * 64 + dg * 8;
            else if (c >= 126 && kk >= (c - cs) * 64) dst = p.out + O_VP + ((size_t)(b * 128 + (c - 126) * 64 + (kk - (c - cs) * 64)) * 4 + kvh) * 64 + dg * 8;
            if (dst) { *(float4*)dst = make_float4(v[0], v[1], v[2], v[3]); *(float4*)(dst + 4) = make_float4(v[4], v[5], v[6], v[7]); }
        }
#pragma unroll
        for (int e = 0; e < 8; ++e) Vt[(dg * 8 + e) * VT_STRIDE + key] = f2bf(v[e]);
    }
    __syncthreads();
    const int nqt_h = NQ >> 4, nqt = 4 * nqt_h, nkt = nkeys >> 4;
    for (int qt = wave; qt < nqt; qt += 8) {
        const int g = qt / nqt_h, r0 = (qt - g * nqt_h) * 16, hq = kvh * 4 + g;
        bf16_t* qp = Q + (tq0 + r0 + fr) * 1024 + hq * 64 + fq * 8;
        bf16x8 q0 = *(const bf16x8*)qp, q1 = *(const bf16x8*)(qp + 32);
        { const float2* rp = rope + (size_t)(pos_q0 + r0 + fr) * 8;
#pragma unroll
          for (int j = 0; j < 8; ++j) { const float mine = bf2f_s(q0[j]); const float other = __shfl_xor(mine, 16); const float2 cssn = rp[j];
              const float nv = (fq == 0) ? mine * cssn.x - other * cssn.y : mine * cssn.x + other * cssn.y;
              if (fq < 2) q0[j] = (short)f2bf(nv); } }
        f32x4 sacc[12];
#pragma unroll
        for (int kt = 0; kt < 12; ++kt) { sacc[kt] = (f32x4){0.f, 0.f, 0.f, 0.f};
            if (kt < nkt) { const bf16_t* kp = Ks + (kt * 16 + fr) * KS_STRIDE + fq * 8;
                sacc[kt] = __builtin_amdgcn_mfma_f32_16x16x32_bf16(*(const bf16x8*)kp, q0, sacc[kt], 0, 0, 0);
                sacc[kt] = __builtin_amdgcn_mfma_f32_16x16x32_bf16(*(const bf16x8*)(kp + 32), q1, sacc[kt], 0, 0, 0); } }
        const float sk = p.sinks[hq];
        float m = sk;
#pragma unroll
        for (int kt = 0; kt < 12; ++kt) if (kt < nkt) {
#pragma unroll
            for (int r = 0; r < 4; ++r) { sacc[kt][r] *= 0.125f; m = fmaxf(m, sacc[kt][r]); } }
        m = fmaxf(m, __shfl_xor(m, 16)); m = fmaxf(m, __shfl_xor(m, 32));
        float sum = 0.f;
#pragma unroll
        for (int kt = 0; kt < 12; ++kt) if (kt < nkt) {
#pragma unroll
            for (int r = 0; r < 4; ++r) { const float e = __expf(sacc[kt][r] - m); sacc[kt][r] = e; sum += e; } }
        sum += __shfl_xor(sum, 16); sum += __shfl_xor(sum, 32);
        const float inv = 1.0f / (sum + __expf(sk - m));
        f32x4 oacc[4];
#pragma unroll
        for (int dt = 0; dt < 4; ++dt) oacc[dt] = (f32x4){0.f, 0.f, 0.f, 0.f};
#pragma unroll
        for (int kk = 0; kk < 6; ++kk) if (2 * kk < nkt) {
            union { bf16x8 v; unsigned u[4]; } pb;
            pb.u[0] = pk2(sacc[2 * kk][0], sacc[2 * kk][1]); pb.u[1] = pk2(sacc[2 * kk][2], sacc[2 * kk][3]);
            pb.u[2] = pk2(sacc[2 * kk + 1][0], sacc[2 * kk + 1][1]); pb.u[3] = pk2(sacc[2 * kk + 1][2], sacc[2 * kk + 1][3]);
#pragma unroll
            for (int dt = 0; dt < 4; ++dt) { const bf16_t* vp = Vt + (dt * 16 + fr) * VT_STRIDE + kk * 32 + fq * 4;
                union { bf16x8 v; u32x2 h[2]; } va; va.h[0] = *(const u32x2*)vp; va.h[1] = *(const u32x2*)(vp + 16);
                oacc[dt] = __builtin_amdgcn_mfma_f32_16x16x32_bf16(va.v, pb.v, oacc[dt], 0, 0, 0); } }
#pragma unroll
        for (int dt = 0; dt < 4; ++dt) { const size_t off = (tq0 + r0 + fr) * 1024 + hq * 64 + dt * 16 + fq * 4;
            const u32x2 gw = *(const u32x2*)(GT + off);
            const float g0 = __uint_as_float(gw.x << 16), g1 = __uint_as_float(gw.x & 0xffff0000u), g2 = __uint_as_float(gw.y << 16), g3 = __uint_as_float(gw.y & 0xffff0000u);
            u32x2 o; o.x = pk2(oacc[dt][0] * inv * siluf_(g0), oacc[dt][1] * inv * siluf_(g1)); o.y = pk2(oacc[dt][2] * inv * siluf_(g2), oacc[dt][3] * inv * siluf_(g3));
            *(u32x2*)(Q + off) = o; }
    }
}

constexpr int K2_SLOT = 64 * KS_STRIDE;
constexpr int V2_STRIDE = 264;
constexpr int K2_OFF = 0, V2_OFF = 4 * K2_SLOT * 2;

__device__ __forceinline__ void attn_run(const Params& p, unsigned char* lds, const int b, const int kvh, const int c0) {
    const int tid = threadIdx.x, lane = tid & 63, wave = tid >> 6, fr = lane & 15, fq = lane >> 4;
    bf16_t* Q = (bf16_t*)(p.ws + W_Q); const bf16_t* K = (const bf16_t*)(p.ws + W_K); const bf16_t* V = (const bf16_t*)(p.ws + W_V);
    const bf16_t* GT = (const bf16_t*)(p.ws + W_G); const float2* rope = (const float2*)(p.ws + W_ROPE);
    bf16_t* Ks = (bf16_t*)(lds + K2_OFF); bf16_t* Vt = (bf16_t*)(lds + V2_OFF);
    const int kkey = tid >> 2, ki = tid & 3;
    const int vkey = tid & 63, vdg = tid >> 6;
    const size_t tb0 = (size_t)b * 8192;
    u32x4 rka = {0u, 0u, 0u, 0u}, rkb = rka, rv = rka; f32x4 rkr[4];
#pragma unroll
    for (int j = 0; j < 4; ++j) rkr[j] = (f32x4){1.f, 0.f, 1.f, 0.f};
#define A2_LOAD(cc) do { if (tid < 256) { const bf16_t* s_ = K + (tb0 + (size_t)(cc) * 64 + kkey) * 256 + kvh * 64 + ki * 16; rka = *(const u32x4*)s_; rkb = *(const u32x4*)(s_ + 8); \
            if (ki == 0) { const f32x4* rp4_ = (const f32x4*)(rope + (size_t)((cc) * 64 + kkey) * 8); _Pragma("unroll") for (int j = 0; j < 4; ++j) rkr[j] = rp4_[j]; } } \
        rv = *(const u32x4*)(V + (tb0 + (size_t)(cc) * 64 + vkey) * 256 + kvh * 64 + vdg * 8); } while (0)
#define A2_WRITE(cc) do { const int sl_ = (cc) & 3; \
        if (tid < 256) { float a_[8], b_[8]; unpack8(rka, a_); unpack8(rkb, b_); \
            if (ki == 0) { \
                _Pragma("unroll") for (int j = 0; j < 8; ++j) { const float cc_ = rkr[j >> 1][(j & 1) * 2], ss_ = rkr[j >> 1][(j & 1) * 2 + 1]; const float x1_ = a_[j], x2_ = b_[j]; a_[j] = x1_ * cc_ - x2_ * ss_; b_[j] = x2_ * cc_ + x1_ * ss_; } } \
            if ((cc) >= 126) { float* d_ = p.out + O_KP + ((size_t)(b * 128 + ((cc) - 126) * 64 + kkey) * 4 + kvh) * 64 + ki * 16; \
                *(float4*)d_ = make_float4(a_[0], a_[1], a_[2], a_[3]); *(float4*)(d_ + 4) = make_float4(a_[4], a_[5], a_[6], a_[7]); *(float4*)(d_ + 8) = make_float4(b_[0], b_[1], b_[2], b_[3]); *(float4*)(d_ + 12) = make_float4(b_[4], b_[5], b_[6], b_[7]); } \
            *(u32x4*)(Ks + sl_ * K2_SLOT + kkey * KS_STRIDE + ki * 16) = pack8(a_); *(u32x4*)(Ks + sl_ * K2_SLOT + kkey * KS_STRIDE + ki * 16 + 8) = pack8(b_); } \
        { if ((cc) >= 126) { float v_[8]; unpack8(rv, v_); float* d_ = p.out + O_VP + ((size_t)(b * 128 + ((cc) - 126) * 64 + vkey) * 4 + kvh) * 64 + vdg * 8; \
              *(float4*)d_ = make_float4(v_[0], v_[1], v_[2], v_[3]); *(float4*)(d_ + 4) = make_float4(v_[4], v_[5], v_[6], v_[7]); } \
          const unsigned vw_[4] = {rv.x, rv.y, rv.z, rv.w}; \
          _Pragma("unroll") for (int e = 0; e < 8; ++e) Vt[(vdg * 8 + e) * V2_STRIDE + sl_ * 64 + vkey] = (bf16_t)((e & 1) ? (vw_[e >> 1] >> 16) : (vw_[e >> 1] & 0xffffu)); } } while (0)
    __syncthreads();
    for (int cc = c0 - 2; cc <= c0; ++cc) if (cc >= 0) { A2_LOAD(cc); A2_WRITE(cc); }
    if (c0 + 1 < 128) A2_LOAD(c0 + 1);
    for (int u = 0; u < 16; ++u) {
        const int c = c0 + u;
        __syncthreads();
        const size_t tq0 = tb0 + (size_t)c * 64;
        bf16x8 q0v[2], q1v[2]; f32x4 csv[2][4];
#pragma unroll
        for (int qi = 0; qi < 2; ++qi) { const int qt = wave * 2 + qi; const bf16_t* qp = Q + (tq0 + (qt & 3) * 16 + fr) * 1024 + (kvh * 4 + (qt >> 2)) * 64 + fq * 8; q0v[qi] = *(const bf16x8*)qp; q1v[qi] = *(const bf16x8*)(qp + 32);
            const f32x4* rp4 = (const f32x4*)(rope + (size_t)(c * 64 + (qt & 3) * 16 + fr) * 8);
#pragma unroll
            for (int j = 0; j < 4; ++j) csv[qi][j] = rp4[j]; }
        if (u + 1 < 16) A2_WRITE(c + 1);
        if (u + 2 < 16) A2_LOAD(c + 2);
#pragma unroll
        for (int qi = 0; qi < 2; ++qi) {
            const int qt = wave * 2 + qi, g = qt >> 2, r0 = (qt & 3) * 16, hq = kvh * 4 + g;
            bf16x8 q0 = q0v[qi], q1 = q1v[qi];
            u32x2 gw[4];
#pragma unroll
            for (int dt = 0; dt < 4; ++dt) gw[dt] = *(const u32x2*)(GT + (tq0 + r0 + fr) * 1024 + hq * 64 + dt * 16 + fq * 4);
            {
#pragma unroll
              for (int j = 0; j < 8; ++j) { const float mine = bf2f_s(q0[j]); const float other = __shfl_xor(mine, 16); const float cs_c = csv[qi][j >> 1][(j & 1) * 2], cs_s = csv[qi][j >> 1][(j & 1) * 2 + 1];
                  const float nv = (fq == 0) ? mine * cs_c - other * cs_s : mine * cs_c + other * cs_s;
                  if (fq < 2) q0[j] = (short)f2bf(nv); } }
            f32x4 sacc[12];
#pragma unroll
            for (int kt = 0; kt < 12; ++kt) { sacc[kt] = (f32x4){0.f, 0.f, 0.f, 0.f}; const int cc = c - 2 + (kt >> 2);
                if (cc >= 0) { const bf16_t* kp = Ks + (cc & 3) * K2_SLOT + ((kt & 3) * 16 + fr) * KS_STRIDE + fq * 8;
                    sacc[kt] = __builtin_amdgcn_mfma_f32_16x16x32_bf16(*(const bf16x8*)kp, q0, sacc[kt], 0, 0, 0);
                    sacc[kt] = __builtin_amdgcn_mfma_f32_16x16x32_bf16(*(const bf16x8*)(kp + 32), q1, sacc[kt], 0, 0, 0); } }
            const float sk = p.sinks[hq];
            float m = sk;
#pragma unroll
            for (int kt = 0; kt < 12; ++kt) if (c - 2 + (kt >> 2) >= 0) {
#pragma unroll
                for (int r = 0; r < 4; ++r) { sacc[kt][r] *= 0.125f; m = fmaxf(m, sacc[kt][r]); } }
            m = fmaxf(m, __shfl_xor(m, 16)); m = fmaxf(m, __shfl_xor(m, 32));
            float sum = 0.f;
#pragma unroll
            for (int kt = 0; kt < 12; ++kt) if (c - 2 + (kt >> 2) >= 0) {
#pragma unroll
                for (int r = 0; r < 4; ++r) { const float e = __expf(sacc[kt][r] - m); sacc[kt][r] = e; sum += e; } }
            sum += __shfl_xor(sum, 16); sum += __shfl_xor(sum, 32);
            const float inv = 1.0f / (sum + __expf(sk - m));
            f32x4 oacc[4];
#pragma unroll
            for (int dt = 0; dt < 4; ++dt) oacc[dt] = (f32x4){0.f, 0.f, 0.f, 0.f};
#pragma unroll
            for (int kk = 0; kk < 6; ++kk) { const int cc = c - 2 + (kk >> 1); if (cc >= 0) {
                union { bf16x8 v; unsigned u[4]; } pb;
                pb.u[0] = pk2(sacc[2 * kk][0], sacc[2 * kk][1]); pb.u[1] = pk2(sacc[2 * kk][2], sacc[2 * kk][3]);
                pb.u[2] = pk2(sacc[2 * kk + 1][0], sacc[2 * kk + 1][1]); pb.u[3] = pk2(sacc[2 * kk + 1][2], sacc[2 * kk + 1][3]);
#pragma unroll
                for (int dt = 0; dt < 4; ++dt) { const bf16_t* vp = Vt + (dt * 16 + fr) * V2_STRIDE + (cc & 3) * 64 + (kk & 1) * 32 + fq * 4;
                    union { bf16x8 v; u32x2 h[2]; } va; va.h[0] = *(const u32x2*)vp; va.h[1] = *(const u32x2*)(vp + 16);
                    oacc[dt] = __builtin_amdgcn_mfma_f32_16x16x32_bf16(va.v, pb.v, oacc[dt], 0, 0, 0); } } }
#pragma unroll
            for (int dt = 0; dt < 4; ++dt) { const size_t off = (tq0 + r0 + fr) * 1024 + hq * 64 + dt * 16 + fq * 4;
                const float g0 = __uint_as_float(gw[dt].x << 16), g1 = __uint_as_float(gw[dt].x & 0xffff0000u), g2 = __uint_as_float(gw[dt].y << 16), g3 = __uint_as_float(gw[dt].y & 0xffff0000u);
                u32x2 o; o.x = pk2(oacc[dt][0] * inv * siluf_(g0), oacc[dt][1] * inv * siluf_(g1)); o.y = pk2(oacc[dt][2] * inv * siluf_(g2), oacc[dt][3] * inv * siluf_(g3));
                *(u32x2*)(Q + off) = o; }
        }
    }
#undef A2_LOAD
#undef A2_WRITE
}

__device__ __forceinline__ void grid_bar(unsigned* word, unsigned G);
typedef unsigned u32x3 __attribute__((ext_vector_type(3)));
__device__ __forceinline__ void unpack6(const u32x3 w, float (&v)[6]) {
    v[0] = __uint_as_float(w.x << 16); v[1] = __uint_as_float(w.x & 0xffff0000u); v[2] = __uint_as_float(w.y << 16); v[3] = __uint_as_float(w.y & 0xffff0000u); v[4] = __uint_as_float(w.z << 16); v[5] = __uint_as_float(w.z & 0xffff0000u);
}
__device__ __forceinline__ void conv_rows(bf16_t* rowp0, const int nrows, float (&w0)[6], float (&w1)[6], float (&w2)[6], const float (&cwt)[4][6], const float (&cb)[6], float* tail_dst) {
    u32x3 cur[8], n1[8], n2[8];
#pragma unroll
    for (int k = 0; k < 8; ++k) { cur[k] = *(const u32x3*)(rowp0 + (size_t)k * 3072); n1[k] = *(const u32x3*)(rowp0 + (size_t)(8 + k) * 3072); }
    for (int r4 = 0; r4 < nrows; r4 += 8) {
        const bool more = r4 + 16 < nrows;
#pragma unroll
        for (int k = 0; k < 8; ++k) n2[k] = more ? *(const u32x3*)(rowp0 + (size_t)(r4 + 16 + k) * 3072) : n1[k];
#pragma unroll
        for (int k = 0; k < 8; ++k) {
            float x3[6]; unpack6(cur[k], x3);
            if (tail_dst && r4 + k >= nrows - 3) { float* d = tail_dst + (size_t)(r4 + k - (nrows - 3)) * 3072; *(float2*)d = make_float2(x3[0], x3[1]); *(float2*)(d + 2) = make_float2(x3[2], x3[3]); *(float2*)(d + 4) = make_float2(x3[4], x3[5]); }
            float y[6];
#pragma unroll
            for (int e = 0; e < 6; ++e) { y[e] = cb[e] + cwt[0][e] * w0[e] + cwt[1][e] * w1[e] + cwt[2][e] * w2[e] + cwt[3][e] * x3[e]; y[e] = siluf_(y[e]); w0[e] = w1[e]; w1[e] = w2[e]; w2[e] = x3[e]; }
            u32x3 o; o.x = pk2(y[0], y[1]); o.y = pk2(y[2], y[3]); o.z = pk2(y[4], y[5]);
            *(u32x3*)(rowp0 + (size_t)(r4 + k) * 3072) = o;
        }
#pragma unroll
        for (int k = 0; k < 8; ++k) { cur[k] = n1[k]; n1[k] = n2[k]; }
    }
}
__device__ __forceinline__ void conv_prepass(const Params& p, unsigned* barword, const int G) {
    const int tid = threadIdx.x, bid = blockIdx.x;
    bf16_t* XBC = (bf16_t*)(p.ws + W_XBC);
    const int ch0 = tid * 6;
    u32x3 h0 = {0u, 0u, 0u}, h1 = h0, h2 = h0;
    if (bid < 256) {
        const int b = bid & 7, blk = bid >> 3; const size_t rbase = (size_t)b * 8192 + (size_t)blk * 256;
        if (blk > 0) { h0 = *(const u32x3*)(XBC + (rbase - 3) * 3072 + ch0); h1 = *(const u32x3*)(XBC + (rbase - 2) * 3072 + ch0); h2 = *(const u32x3*)(XBC + (rbase - 1) * 3072 + ch0); }
    }
    grid_bar(barword, (unsigned)G);
    float cwt[4][6], cb[6];
#pragma unroll
    for (int t = 0; t < 4; ++t)
#pragma unroll
        for (int e = 0; e < 6; e += 2) { const float2 a = *(const float2*)(p.conv_w + t * 3072 + ch0 + e); cwt[t][e] = a.x; cwt[t][e + 1] = a.y; }
#pragma unroll
    for (int e = 0; e < 6; e += 2) { const float2 a = *(const float2*)(p.conv_b + ch0 + e); cb[e] = a.x; cb[e + 1] = a.y; }
    if (bid < 256) {
        const int b = bid & 7, blk = bid >> 3; const size_t rbase = (size_t)b * 8192 + (size_t)blk * 256;
        float w0[6], w1[6], w2[6]; unpack6(h0, w0); unpack6(h1, w1); unpack6(h2, w2);
        conv_rows(XBC + rbase * 3072 + ch0, 256, w0, w1, w2, cwt, cb, blk == 31 ? p.out + O_CP + (size_t)b * 3 * 3072 + ch0 : nullptr);
    }
    if (bid < 16) {
        const int sb = bid; const float* sc = p.state_conv + (size_t)sb * 3 * 3072 + ch0;
        float w0[6], w1[6], w2[6];
#pragma unroll
        for (int e = 0; e < 6; ++e) { w0[e] = sc[e]; w1[e] = sc[3072 + e]; w2[e] = sc[2 * 3072 + e]; }
        conv_rows(XBC + ((size_t)TP + sb * 32) * 3072 + ch0, 32, w0, w1, w2, cwt, cb, p.out + O_CS + (size_t)sb * 3 * 3072 + ch0);
    }
}

constexpr int CS_OFF = 0, BS_OFF = 17408, BT_OFF = 34816, XT_OFF = 53248, MS_OFF = 62464, HS_OFF = 71680, YS_OFF = 89088, SC_OFF = 106496;
constexpr int ST136 = 136, ST72 = 72, YS_ST = 68;

__device__ __forceinline__ void ssd_seq(const Params& p, unsigned char* lds, const int is_sample, const int b, const int h) {
    const int tid = threadIdx.x, lane = tid & 63, wave = tid >> 6, fr = lane & 15, fq = lane >> 4;
    const int g = h >> 3;
    const bf16_t* XBC = (const bf16_t*)(p.ws + W_XBC); bf16_t* Z = (bf16_t*)(p.ws + W_Z); const float* DT = (const float*)(p.ws + W_DT); float* SSQG = (float*)(p.ws + W_SSQG);
    bf16_t* Cs = (bf16_t*)(lds + CS_OFF); bf16_t* Bs = (bf16_t*)(lds + BS_OFF); bf16_t* Bt = (bf16_t*)(lds + BT_OFF); bf16_t* Xt = (bf16_t*)(lds + XT_OFF);
    bf16_t* Ms = (bf16_t*)(lds + MS_OFF); bf16_t* Hs = (bf16_t*)(lds + HS_OFF); float* Ys = (float*)(lds + YS_OFF);
    float* dt_s = (float*)(lds + SC_OFF); float* cum_s = dt_s + 64; float* ecum_s = dt_s + 128; float* toend_s = dt_s + 192;
    const int nchunks = is_sample ? 1 : 128, Lc = is_sample ? 32 : 64;
    const size_t tseq0 = is_sample ? (size_t)TP + b * 32 : (size_t)b * 8192;
    const float a_h = -__expf(p.a_log[h]); const float d_h = p.d_skip[h];
    const int xrow = tid >> 3, xcg = tid & 7;
    const int brow = tid >> 4, bcg = tid & 15;
    const int erow = tid >> 3, epg = tid & 7;
    const int pt = wave & 3, nt0 = (wave >> 2) * 4, it = wave >> 1;
    f32x4 Hacc[4];
#pragma unroll
    for (int k = 0; k < 4; ++k)
#pragma unroll
        for (int r = 0; r < 4; ++r) Hacc[k][r] = is_sample ? p.state_ssm[((size_t)(b * 32 + h) * 64 + pt * 16 + fq * 4 + r) * 128 + (nt0 + k) * 16 + fr] : 0.f;
    u32x4 rx = {0u, 0u, 0u, 0u}, rb0 = rx, rb1 = rx, rc0 = rx, rc1 = rx, rz = rx; float rdt = 0.f;
#define SSD_LOAD_CHUNK(c) do { const size_t t0c_ = tseq0 + (size_t)(c) * 64; \
        if (xrow < Lc) rx = *(const u32x4*)(XBC + (t0c_ + xrow) * 3072 + h * 64 + xcg * 8); \
        { const bf16_t* rp_ = XBC + (t0c_ + brow) * 3072 + 2048 + g * 128 + bcg * 8; rb0 = *(const u32x4*)rp_; rc0 = *(const u32x4*)(rp_ + 512); \
          if (Lc == 64) { rb1 = *(const u32x4*)(rp_ + (size_t)32 * 3072); rc1 = *(const u32x4*)(rp_ + (size_t)32 * 3072 + 512); } } \
        if (wave == 0) rdt = lane < Lc ? DT[(t0c_ + lane) * 32 + h] : 0.f; } while (0)
#define SSD_EPILOGUE(c) do { const size_t t0e_ = tseq0 + (size_t)(c) * 64; \
        if (erow < Lc) { const float4 y0 = *(const float4*)(Ys + erow * YS_ST + epg * 8), y1 = *(const float4*)(Ys + erow * YS_ST + epg * 8 + 4); \
            float z_[8]; unpack8(rz, z_); float v_[8] = {y0.x, y0.y, y0.z, y0.w, y1.x, y1.y, y1.z, y1.w}; float ss_ = 0.f; \
            _Pragma("unroll") for (int e = 0; e < 8; ++e) { v_[e] *= siluf_(z_[e]); ss_ += v_[e] * v_[e]; } \
            *(u32x4*)(Z + (t0e_ + erow) * 2048 + h * 64 + epg * 8) = pack8(v_); \
            ss_ += __shfl_xor(ss_, 1); ss_ += __shfl_xor(ss_, 2); ss_ += __shfl_xor(ss_, 4); \
            if (epg == 0) SSQG[(t0e_ + erow) * 32 + h] = ss_; } } while (0)
#define SSD_T16(dst, w, e) dst = (bf16_t)((e) & 1 ? ((w) >> 16) : ((w) & 0xffffu))
    SSD_LOAD_CHUNK(0);
    for (int c = 0; c < nchunks; ++c) {
        __syncthreads();
        if (c > 0) SSD_EPILOGUE(c - 1);
        { const unsigned xw[4] = {rx.x, rx.y, rx.z, rx.w}, b0w[4] = {rb0.x, rb0.y, rb0.z, rb0.w}, b1w[4] = {rb1.x, rb1.y, rb1.z, rb1.w};
          const int xpos = (((xrow >> 3) ^ xcg) << 3) + (xrow & 7), bpos0 = (((brow >> 3) ^ (bcg & 7)) << 3) + (brow & 7), bpos1 = ((((brow + 32) >> 3) ^ (bcg & 7)) << 3) + (brow & 7);
#pragma unroll
          for (int e = 0; e < 8; ++e) { SSD_T16(Xt[(xcg * 8 + e) * ST72 + xpos], xw[e >> 1], e); SSD_T16(Bt[(bcg * 8 + e) * ST72 + bpos0], b0w[e >> 1], e); SSD_T16(Bt[(bcg * 8 + e) * ST72 + bpos1], b1w[e >> 1], e); }
          *(u32x4*)(Bs + brow * ST136 + bcg * 8) = rb0; *(u32x4*)(Bs + (brow + 32) * ST136 + bcg * 8) = rb1;
          *(u32x4*)(Cs + brow * ST136 + bcg * 8) = rc0; *(u32x4*)(Cs + (brow + 32) * ST136 + bcg * 8) = rc1; }
        if (wave == 0) {
            float x = rdt * a_h;
#pragma unroll
            for (int off = 1; off < 64; off <<= 1) { const float y = __shfl_up(x, off); if (lane >= off) x += y; }
            const float cl = __shfl(x, 63);
            dt_s[lane] = rdt; cum_s[lane] = x; ecum_s[lane] = __expf(x); toend_s[lane] = __expf(cl - x) * rdt;
        }
#pragma unroll
        for (int k = 0; k < 4; ++k) { const unsigned w01 = pk2(Hacc[k][0], Hacc[k][1]), w23 = pk2(Hacc[k][2], Hacc[k][3]); bf16_t* hp = Hs + (pt * 16 + fq * 4) * ST136 + (nt0 + k) * 16 + fr;
            hp[0] = (bf16_t)(w01 & 0xffffu); hp[ST136] = (bf16_t)(w01 >> 16); hp[2 * ST136] = (bf16_t)(w23 & 0xffffu); hp[3 * ST136] = (bf16_t)(w23 >> 16); }
        if (erow < Lc) rz = *(const u32x4*)(Z + (tseq0 + (size_t)c * 64 + erow) * 2048 + h * 64 + epg * 8);
        if (c + 1 < nchunks) SSD_LOAD_CHUNK(c + 1);
        __syncthreads();
#pragma unroll
        for (int jj = 0; jj < 2; ++jj) {
            const int jt = (wave & 1) * 2 + jj;
            f32x4 acc = {0.f, 0.f, 0.f, 0.f};
            if (jt <= it) {
#pragma unroll
                for (int ks = 0; ks < 4; ++ks) acc = __builtin_amdgcn_mfma_f32_16x16x32_bf16(*(const bf16x8*)(Cs + (it * 16 + fr) * ST136 + ks * 32 + fq * 8), *(const bf16x8*)(Bs + (jt * 16 + fr) * ST136 + ks * 32 + fq * 8), acc, 0, 0, 0);
            }
            const int j = jt * 16 + fr; const float cj = cum_s[j], dj = dt_s[j];
            float mv[4];
#pragma unroll
            for (int r = 0; r < 4; ++r) { const int i = it * 16 + fq * 4 + r;
                float val = (jt <= it && j <= i) ? acc[r] * __expf(cum_s[i] - cj) * dj : 0.f;
                if (i == j) val += d_h;
                mv[r] = val; }
            { const unsigned w01 = pk2(mv[0], mv[1]), w23 = pk2(mv[2], mv[3]); bf16_t* mp = Ms + (it * 16 + fq * 4) * ST72 + j;
              mp[0] = (bf16_t)(w01 & 0xffffu); mp[ST72] = (bf16_t)(w01 >> 16); mp[2 * ST72] = (bf16_t)(w23 & 0xffffu); mp[3 * ST72] = (bf16_t)(w23 >> 16); }
        }
        f32x4 accY[2];
#pragma unroll
        for (int pp = 0; pp < 2; ++pp) { const int ptile = (wave & 1) * 2 + pp; accY[pp] = (f32x4){0.f, 0.f, 0.f, 0.f};
#pragma unroll
            for (int ks = 0; ks < 4; ++ks) accY[pp] = __builtin_amdgcn_mfma_f32_16x16x32_bf16(*(const bf16x8*)(Cs + (it * 16 + fr) * ST136 + ks * 32 + fq * 8), *(const bf16x8*)(Hs + (ptile * 16 + fr) * ST136 + ks * 32 + fq * 8), accY[pp], 0, 0, 0);
#pragma unroll
            for (int r = 0; r < 4; ++r) accY[pp][r] *= ecum_s[it * 16 + fq * 4 + r]; }
        __syncthreads();
#pragma unroll
        for (int pp = 0; pp < 2; ++pp) { const int ptile = (wave & 1) * 2 + pp;
#pragma unroll
            for (int ks = 0; ks < 2; ++ks) if (ks * 32 <= it * 16 + 15)
                accY[pp] = __builtin_amdgcn_mfma_f32_16x16x32_bf16(*(const bf16x8*)(Ms + (it * 16 + fr) * ST72 + ks * 32 + fq * 8), *(const bf16x8*)(Xt + (ptile * 16 + fr) * ST72 + (((ks * 4 + fq) ^ ((ptile * 2 + (fr >> 3)) & 7)) << 3)), accY[pp], 0, 0, 0);
#pragma unroll
            for (int r = 0; r < 4; ++r) Ys[(it * 16 + fq * 4 + r) * YS_ST + ptile * 16 + fr] = accY[pp][r]; }
        { const float dec = ecum_s[63];
          bf16x8 xa[2];
#pragma unroll
          for (int ks = 0; ks < 2; ++ks) { float xv[8]; unpack8(*(const u32x4*)(Xt + (pt * 16 + fr) * ST72 + (((ks * 4 + fq) ^ ((pt * 2 + (fr >> 3)) & 7)) << 3)), xv);
              const float4 t0 = *(const float4*)(toend_s + ks * 32 + fq * 8), t1 = *(const float4*)(toend_s + ks * 32 + fq * 8 + 4);
              xv[0] *= t0.x; xv[1] *= t0.y; xv[2] *= t0.z; xv[3] *= t0.w; xv[4] *= t1.x; xv[5] *= t1.y; xv[6] *= t1.z; xv[7] *= t1.w;
              union { u32x4 u; bf16x8 v; } cvt; cvt.u = pack8(xv); xa[ks] = cvt.v; }
#pragma unroll
          for (int k = 0; k < 4; ++k) {
#pragma unroll
              for (int r = 0; r < 4; ++r) Hacc[k][r] *= dec;
#pragma unroll
              for (int ks = 0; ks < 2; ++ks) Hacc[k] = __builtin_amdgcn_mfma_f32_16x16x32_bf16(xa[ks], *(const bf16x8*)(Bt + ((nt0 + k) * 16 + fr) * ST72 + (((ks * 4 + fq) ^ (((nt0 + k) * 2 + (fr >> 3)) & 7)) << 3)), Hacc[k], 0, 0, 0); } }
    }
    __syncthreads();
    SSD_EPILOGUE(nchunks - 1);
#undef SSD_LOAD_CHUNK
#undef SSD_EPILOGUE
#undef SSD_T16
    float* hs = p.out + (is_sample ? O_SS : O_SP) + (size_t)(b * 32 + h) * 64 * 128;
#pragma unroll
    for (int k = 0; k < 4; ++k)
#pragma unroll
        for (int r = 0; r < 4; ++r) hs[(pt * 16 + fq * 4 + r) * 128 + (nt0 + k) * 16 + fr] = Hacc[k][r];
}

struct TileOrder {
    int ntiles, nwg, c;
    __device__ __forceinline__ bool next(int i, pg8::Unit& u) const { const int L = i * nwg + c; if (L >= ntiles) return false; const int q = L & 7, r = L >> 3; u.pn = r & 3; u.pm = ((r >> 2) << 3) + q; return true; }
    __device__ __forceinline__ void a_ready(const pg8::Unit&) const {}
    __device__ __forceinline__ void done(const pg8::Unit&) const {}
};
struct SampleOrder {
    int c;
    __device__ __forceinline__ bool next(int i, pg8::Unit& u) const { if (i > 0) return false; u.pm = 256 + (c >> 2); u.pn = c & 3; return true; }
    __device__ __forceinline__ void a_ready(const pg8::Unit&) const {}
    __device__ __forceinline__ void done(const pg8::Unit&) const {}
};
typedef EpiOutT<0> EpiOut;
__device__ __forceinline__ void post_rows(const Params& p, int t0, const int t1, const int tstride, const int lane) {
    const float* SSQO = (const float*)(p.ws + W_SSQO);
    float4 w[4];
#pragma unroll
    for (int i = 0; i < 4; ++i) w[i] = *(const float4*)(p.post_norm_w + i * 256 + lane * 4);
    float4 xv[2][4], nx[2][4]; u32x2 ov[2][4], no[2][4]; float sp[2], ns[2];
#define PR_LOAD(XV, OV, SP, tb_) do { _Pragma("unroll") for (int k = 0; k < 2; ++k) { const int t_ = (tb_) + k * tstride; const int tt_ = t_ < t1 ? t_ : t0; \
        const float* xr_ = tt_ < TP ? p.x_prompt + (size_t)tt_ * DM : p.x_sample + (size_t)(tt_ - TP) * DM; const bf16_t* or_ = (const bf16_t*)(p.ws + W_Z) + (size_t)tt_ * DM; \
        SP[k] = lane < 16 ? SSQO[(size_t)tt_ * 16 + lane] : 0.f; \
        _Pragma("unroll") for (int i = 0; i < 4; ++i) { XV[k][i] = *(const float4*)(xr_ + i * 256 + lane * 4); OV[k][i] = *(const u32x2*)(or_ + i * 256 + lane * 4); } } } while (0)
    int tb = t0;
    if (tb < t1) PR_LOAD(xv, ov, sp, tb);
    for (; tb < t1; tb += 2 * tstride) {
        if (tb + 2 * tstride < t1) PR_LOAD(nx, no, ns, tb + 2 * tstride);
#pragma unroll
        for (int k = 0; k < 2; ++k) { const int t = tb + k * tstride; if (t < t1) {
            float s = sp[k]; s += __shfl_xor(s, 1); s += __shfl_xor(s, 2); s += __shfl_xor(s, 4); s += __shfl_xor(s, 8); s = __shfl(s, 0);
            const float r = rsqrtf(s * (1.0f / 1024.0f) + 1e-6f); float* yr = p.out + (size_t)t * DM;
#pragma unroll
            for (int i = 0; i < 4; ++i) { const float4 x = xv[k][i]; const u32x2 ow = ov[k][i]; const float4 o = make_float4(__uint_as_float(ow.x << 16), __uint_as_float(ow.x & 0xffff0000u), __uint_as_float(ow.y << 16), __uint_as_float(ow.y & 0xffff0000u));
                *(float4*)(yr + i * 256 + lane * 4) = make_float4(x.x + o.x * r * w[i].x, x.y + o.y * r * w[i].y, x.z + o.z * r * w[i].z, x.w + o.w * r * w[i].w); } } }
#pragma unroll
        for (int k = 0; k < 2; ++k) { sp[k] = ns[k];
#pragma unroll
            for (int i = 0; i < 4; ++i) { xv[k][i] = nx[k][i]; ov[k][i] = no[k][i]; } }
    }
#undef PR_LOAD
}

__device__ __forceinline__ void grid_bar(unsigned* word, unsigned G) {
    asm volatile("s_waitcnt vmcnt(0) lgkmcnt(0)" ::: "memory");
    __syncthreads();
    if (threadIdx.x == 0) {
        __builtin_amdgcn_fence(__ATOMIC_RELEASE, "agent");
        asm volatile("s_waitcnt vmcnt(0)" ::: "memory");
        __hip_atomic_fetch_add(word, 1u, __ATOMIC_RELAXED, __HIP_MEMORY_SCOPE_AGENT);
        while (__hip_atomic_load(word, __ATOMIC_RELAXED, __HIP_MEMORY_SCOPE_AGENT) < G) __builtin_amdgcn_s_sleep(4);
        __builtin_amdgcn_fence(__ATOMIC_ACQUIRE, "agent");
        asm volatile("s_waitcnt vmcnt(0)" ::: "memory");
    }
    __syncthreads();
}

__global__ void __launch_bounds__(NTHR, 2) mega_fwd(Params p) {
    extern __shared__ __attribute__((aligned(16))) unsigned char lds[];
    cg::grid_group grid = cg::this_grid();
    const int tid = threadIdx.x, lane = tid & 63, wave = tid >> 6;
    const int G = gridDim.x, bid = blockIdx.x;
    const int lo = p.ph_lo, hi = p.ph_hi;
#define IN(k) (lo <= (k) && (k) < hi)
#define SEAM(k) do { if (IN(k) && IN((k) + 1)) grid_bar((unsigned*)(p.ws + W_BAR) + 32 * (k), (unsigned)G); } while (0)
    grid.sync();
    PG8_LAS unsigned char* glds = (PG8_LAS unsigned char*)lds;
    const bf16_t* Hn = (const bf16_t*)p.out;
    if (IN(0)) p0_prologue(p, lds);
    SEAM(0);
    if (IN(1)) { __syncthreads();
        pg8::Gemm g{Hn, (const bf16_t*)(p.ws + W_WIN), TT, NIN, 1024}; pg8::StaticOrder S; S.init(TT, NIN, G, bid);
        EpiInProj E{p.ws, p.dt_bias}; pg8::gemm_phase<EpiInProj, pg8::StaticOrder>(glds, g, S, E, nullptr); }
    SEAM(1);
    if (IN(2)) conv_prepass(p, (unsigned*)(p.ws + W_BAR) + 16, G);
    SEAM(2);
    if (IN(3)) {
        const int x = bid & 7, kq = bid >> 3;
        const bool std_grid = (G == 256);
        if (std_grid) {
#pragma unroll 1
            for (int k = 0; k < 3; ++k) { const int is_s = k > 0 ? 1 : 0, su = bid * 2 + (k - 1); ssd_seq(p, lds, is_s, is_s ? su >> 5 : x, is_s ? su & 31 : kq); }
            attn_run(p, lds, x, kq & 3, (kq >> 2) * 16);
            if (bid < 64) attn_unit(p, lds, 1, bid >> 2, 0, bid & 3);
        }
    }
    SEAM(3);
    if (IN(4)) {
        bf16_t* Z = (bf16_t*)(p.ws + W_Z); const float* SSQG = (const float*)(p.ws + W_SSQG);
        const size_t nit = (size_t)TT * 256, gs = (size_t)G * NTHR;
        for (size_t i0 = (size_t)bid * NTHR + tid; i0 < nit; i0 += 4 * gs) {
            u32x4 zv[4]; f32x4 s0[4], s1[4];
#pragma unroll
            for (int k = 0; k < 4; ++k) { const size_t i = i0 + k * gs; const size_t ii = i < nit ? i : i0; const size_t t = ii >> 8; const int c8 = (int)(ii & 255);
                s0[k] = *(const f32x4*)(SSQG + t * 32 + (c8 >> 6) * 8); s1[k] = *(const f32x4*)(SSQG + t * 32 + (c8 >> 6) * 8 + 4); zv[k] = *(const u32x4*)(Z + t * 2048 + c8 * 8); }
#pragma unroll
            for (int k = 0; k < 4; ++k) { const size_t i = i0 + k * gs; if (i < nit) { const size_t t = i >> 8; const int c8 = (int)(i & 255);
                const float r = rsqrtf((((s0[k][0] + s0[k][1]) + (s0[k][2] + s0[k][3])) + ((s1[k][0] + s1[k][1]) + (s1[k][2] + s1[k][3]))) * (1.0f / 512.0f) + 1e-6f);
                float v[8]; unpack8(zv[k], v);
#pragma unroll
                for (int e = 0; e < 8; ++e) v[e] *= r;
                *(u32x4*)(Z + t * 2048 + c8 * 8) = pack8(v); } }
        }
    }
    SEAM(4);
    bf16_t* GA = (bf16_t*)(p.ws + W_GA); bf16_t* GS = (bf16_t*)(p.ws + W_GS); bf16_t* MG = (bf16_t*)(p.ws + W_MG);
#define MERGE_CHAIN(SCHED, S) do { \
        { pg8::Gemm g{Hn, (const bf16_t*)(p.ws + W_WG), TT, 1024, 1024}; EpiMerge<0> E{GA, nullptr}; pg8::gemm_phase<EpiMerge<0>, SCHED>(glds, g, S, E, nullptr); } \
        { pg8::Gemm g{Hn, (const bf16_t*)(p.ws + W_WG) + (size_t)1024 * 1024, TT, 1024, 1024}; EpiMerge<0> E{GS, nullptr}; pg8::gemm_phase<EpiMerge<0>, SCHED>(glds, g, S, E, nullptr); } \
        { pg8::Gemm g{(const bf16_t*)(p.ws + W_Q), (const bf16_t*)(p.ws + W_WAO), TT, 1024, 1024}; EpiMerge<1> E{MG, GA}; pg8::gemm_phase<EpiMerge<1>, SCHED>(glds, g, S, E, nullptr); } \
        { pg8::Gemm g{(const bf16_t*)(p.ws + W_Z), (const bf16_t*)(p.ws + W_WSO), TT, 1024, 2048}; EpiMerge<2> E{MG, GS}; pg8::gemm_phase<EpiMerge<2>, SCHED>(glds, g, S, E, nullptr); } } while (0)
#define OUT_GEMM(SCHED, S) do { pg8::Gemm g{(const bf16_t*)(p.ws + W_MG), (const bf16_t*)(p.ws + W_WOUT), TT, 1024, 1024}; \
        EpiOut E{(bf16_t*)(p.ws + W_Z), (float*)(p.ws + W_SSQO)}; pg8::gemm_phase<EpiOut, SCHED>(glds, g, S, E, nullptr); } while (0)
    if (IN(5)) { __syncthreads(); const TileOrder S{1024, G, bid}; MERGE_CHAIN(TileOrder, S); }
    SEAM(5);
    if (IN(6)) { __syncthreads();
        if (bid < 8) { const SampleOrder S{bid};
            { pg8::Gemm g{Hn, (const bf16_t*)(p.ws + W_WG), TT, 1024, 1024}; EpiMerge<0> E{GA, nullptr}; pg8::gemm_phase<EpiMerge<0>, SampleOrder>(glds, g, S, E, nullptr); }
            { pg8::Gemm g{(const bf16_t*)(p.ws + W_Q), (const bf16_t*)(p.ws + W_WAO), TT, 1024, 1024}; EpiMerge<1> E{MG, GA}; pg8::gemm_phase<EpiMerge<1>, SampleOrder>(glds, g, S, E, nullptr); } }
        else if (bid < 16) { const SampleOrder S{bid - 8};
            { pg8::Gemm g{Hn, (const bf16_t*)(p.ws + W_WG) + (size_t)1024 * 1024, TT, 1024, 1024}; EpiMerge<0> E{GS, nullptr}; pg8::gemm_phase<EpiMerge<0>, SampleOrder>(glds, g, S, E, nullptr); }
            { pg8::Gemm g{(const bf16_t*)(p.ws + W_Z), (const bf16_t*)(p.ws + W_WSO), TT, 1024, 2048}; EpiMerge<1> E{GS, GS}; pg8::gemm_phase<EpiMerge<1>, SampleOrder>(glds, g, S, E, nullptr); } }
        else { const TileOrder S{1024, G - 16, bid - 16}; OUT_GEMM(TileOrder, S); } }
    SEAM(6);
    if (IN(7)) {
        if (bid < 8) { __syncthreads(); const SampleOrder S{bid}; OUT_GEMM(SampleOrder, S);
            { pg8::Gemm g{(const bf16_t*)(p.ws + W_GS), (const bf16_t*)(p.ws + W_WOUT), TT, 1024, 1024}; EpiOutT<1> E{(bf16_t*)(p.ws + W_Z), (float*)(p.ws + W_SSQO)}; pg8::gemm_phase<EpiOutT<1>, SampleOrder>(glds, g, S, E, nullptr); } }
        else post_rows(p, (bid - 8) * 8 + wave, TP, (G - 8) * 8, lane); }
    if (IN(7) && bid < 8) { grid_bar((unsigned*)(p.ws + W_BAR) + 20, 8u); post_rows(p, TP + bid * 8 + wave, TT, 8 * 8, lane); }
#undef IN
#undef SEAM
}

extern "C" void kernel_launch(void* const* d_in, const int* in_sizes, int n_in, void* d_out, int out_size, void* d_ws, size_t ws_size, hipStream_t stream) {
    static int grid = 0;
    if (grid == 0) {
        int dev = 0, cus = 0, per_cu = 0;
        (void)hipGetDevice(&dev); (void)hipDeviceGetAttribute(&cus, hipDeviceAttributeMultiprocessorCount, dev);
        (void)hipFuncSetAttribute((const void*)mega_fwd, hipFuncAttributeMaxDynamicSharedMemorySize, LDS_BYTES);
        (void)hipOccupancyMaxActiveBlocksPerMultiprocessor(&per_cu, (const void*)mega_fwd, NTHR, LDS_BYTES);
        if (per_cu < 1) { fprintf(stderr, "kernel_launch: occupancy query says %d blocks per CU\n", per_cu); per_cu = 1; }
        (void)hipGetLastError();
        grid = cus > 0 ? cus : 256;
        if (ws_size < W_END) fprintf(stderr, "kernel_launch: workspace too small: %zu < %zu\n", ws_size, (size_t)W_END);
    }
    Params p{};
    const float** pp = (const float**)&p;
    for (int i = 0; i < 19; ++i) pp[i] = (const float*)d_in[i];
    p.out = (float*)d_out; p.ws = (unsigned char*)d_ws; p.ph_lo = 0; p.ph_hi = 9; p.dbg = 0; p.ws_size = (unsigned long long)ws_size;
    (void)hipMemsetAsync((unsigned char*)d_ws + W_BAR, 0, 1024, stream);
    void* args[] = {&p};
    hipError_t e = hipLaunchCooperativeKernel((const void*)mega_fwd, dim3(grid), dim3(NTHR), args, LDS_BYTES, stream);
    if (e != hipSuccess) fprintf(stderr, "cooperative launch failed: %s (grid %d)\n", hipGetErrorString(e), grid);
}
```
